# Optimizing an MI355X kernel written in HIP

```python
import jax, jax.numpy as jnp
from jax import lax
import numpy as np

D_MODEL = 1024
BATCH = 8
SEQ = 2048
DEPTH = 2
DEC_BATCH = 128
DEC_SEQ = 1
PAST_LEN = 16384
PAGE_SIZE = 128

GM_HEADS = 4
GM_HEAD_DIM = D_MODEL // 8
GM_WIDTH = GM_HEADS * GM_HEAD_DIM
GM_CHUNK = 128
ML_HEADS = 4
ML_HEAD_DIM = D_MODEL // 8
ML_WIDTH = ML_HEADS * ML_HEAD_DIM
ML_CONV = 4
ML_CHUNK = 64
D_MIX = GM_WIDTH + ML_WIDTH
N_IN = 2 * GM_WIDTH + 2 * ML_WIDTH + 2 * ML_HEADS
MEM_TOKENS = 256
XA_HEADS = 4
XA_HEAD_DIM = D_MODEL // XA_HEADS
D_FF = 4 * D_MODEL
EPS = 1e-6
NEG = -1e30

kernel_name = "hybrid_gmlp_mlstm_memxattn_step"


def _rmsnorm(x, g):
    xf = x.astype(jnp.float32)
    y = xf * lax.rsqrt(jnp.mean(xf * xf, axis=-1, keepdims=True) + EPS)
    return (y * g.astype(jnp.float32)).astype(x.dtype)


def _chunk_gmlp(z, v_norm_g, ws, bs):
    z = jax.nn.gelu(z)
    u, v = jnp.split(z, 2, axis=-1)
    v = _rmsnorm(v, v_norm_g)
    B, S, _ = v.shape
    n_chunks = -(-S // GM_CHUNK)
    pad = n_chunks * GM_CHUNK - S
    vp = jnp.pad(v, ((0, 0), (0, pad), (0, 0))).reshape(B, n_chunks, GM_CHUNK, GM_HEADS, GM_HEAD_DIM)
    causal = jnp.tril(jnp.ones((GM_CHUNK, GM_CHUNK), dtype=bool))
    w = jnp.where(causal[None], ws, 0).astype(vp.dtype)
    mixed = jnp.einsum('hts,bnshd->bnthd', w, vp) + bs.T[None, None, :, :, None]
    gate = mixed.reshape(B, n_chunks * GM_CHUNK, GM_WIDTH)[:, :S]
    return u * gate, v


def _causal_conv(x_ext, w, b, S):
    out = b
    for j in range(ML_CONV):
        out = out + x_ext[:, j:j + S] * w[j]
    return out


def _mlstm(q, k, v, ig, lf, C0, n0, m0):
    B, S, H, D = q.shape
    L = min(ML_CHUNK, S)
    nc = -(-S // L)
    pad = nc * L - S
    valid = (jnp.arange(nc * L) < S)[None, :, None]
    padf = lambda a: jnp.pad(a, [(0, 0), (0, pad)] + [(0, 0)] * (a.ndim - 2))
    q, k, v = padf(q), padf(k), padf(v)
    ig = jnp.where(valid, padf(ig), NEG)
    lf = jnp.where(valid, padf(lf), 0.0)
    to_chunks = lambda a: jnp.moveaxis(a.reshape((B, nc, L) + a.shape[2:]), 1, 0)
    causal = jnp.tril(jnp.ones((L, L), dtype=bool))[None, :, :, None]

    def step(carry, inp):
        C, n, m = carry
        qc, kc, vc, igc, lfc = inp
        b = jnp.cumsum(lfc, axis=1)
        a = b + m[:, None, :]
        dlog = jnp.where(causal, b[:, :, None, :] - b[:, None, :, :] + igc[:, None, :, :], NEG)
        mt = jnp.maximum(a, jnp.max(dlog, axis=2))
        w_inter = jnp.exp(a - mt)
        s = jnp.einsum('bthd,bshd->btsh', qc, kc) * jnp.exp(dlog - mt[:, :, None, :])
        num = jnp.einsum('btsh,bshd->bthd', s, vc) + w_inter[..., None] * jnp.einsum('bthk,bhkv->bthv', qc, C)
        den = jnp.sum(s, axis=2) + w_inter * jnp.einsum('bthk,bhk->bth', qc, n)
        h = num / jnp.maximum(jnp.abs(den), jnp.exp(-mt))[..., None]
        bL = b[:, -1]
        aL = bL + m
        wlog = bL[:, None, :] - b + igc
        m_new = jnp.maximum(aL, jnp.max(wlog, axis=1))
        w_s = jnp.exp(wlog - m_new[:, None, :])
        decay = jnp.exp(aL - m_new)
        C_new = decay[..., None, None] * C + jnp.einsum('bsh,bshk,bshv->bhkv', w_s, kc, vc)
        n_new = decay[..., None] * n + jnp.einsum('bsh,bshk->bhk', w_s, kc)
        return (C_new, n_new, m_new), h

    (C, n, m), h = lax.scan(step, (C0, n0, m0), tuple(map(to_chunks, (q, k, v, ig, lf))))
    h = jnp.moveaxis(h, 0, 1).reshape(B, nc * L, H, D)[:, :S]
    return h, C, n, m


def _mem_kv(mem, g_mem, w_ck, w_cv):
    B = mem.shape[0]
    mn = _rmsnorm(mem, g_mem)
    mk = (mn @ w_ck).reshape(B, MEM_TOKENS, XA_HEADS, XA_HEAD_DIM)
    mv = (mn @ w_cv).reshape(B, MEM_TOKENS, XA_HEADS, XA_HEAD_DIM)
    return mk, mv


def _layer(x, mem_k, mem_v, conv_buf, C0, n0, m0, lw):
    (g_mix, w_in, gm_v_g, gm_ws, gm_bs, ml_conv_w, ml_conv_b, ml_wq, ml_wk, ml_wv,
     ml_b_i, ml_b_f, ml_out_g, ml_skip, w_out, g_xa, w_cq, w_co, g_ffn, w_up, w_down) = lw
    f32 = jnp.float32
    B, S, _ = x.shape
    h = _rmsnorm(x, g_mix)
    proj = h @ w_in
    c0 = 2 * GM_WIDTH
    c1 = c0 + ML_WIDTH
    c2 = c1 + ML_WIDTH
    c3 = c2 + ML_HEADS
    z_gm, xm, o_pre, ig_pre, fg_pre = jnp.split(proj, [c0, c1, c2, c3], axis=-1)
    y_gm, v_gm = _chunk_gmlp(z_gm, gm_v_g, gm_ws, gm_bs)
    x_ext = jnp.concatenate([conv_buf.astype(xm.dtype), xm], axis=1)
    conv_act = jax.nn.silu(_causal_conv(x_ext, ml_conv_w, ml_conv_b, S))
    heads = lambda a: a.reshape(B, S, ML_HEADS, ML_HEAD_DIM)
    q = jnp.einsum('bshd,hde->bshe', heads(conv_act), ml_wq)
    k = jnp.einsum('bshd,hde->bshe', heads(conv_act), ml_wk) * (ML_HEAD_DIM ** -0.5)
    v = jnp.einsum('bshd,hde->bshe', heads(xm), ml_wv)
    ig = (ig_pre + ml_b_i).astype(f32)
    lf = jax.nn.log_sigmoid((fg_pre + ml_b_f).astype(f32))
    hc, C, n, m = _mlstm(q.astype(f32), k.astype(f32), v.astype(f32), ig, lf,
                         C0.astype(f32), n0.astype(f32), m0.astype(f32))
    hc = _rmsnorm(hc, ml_out_g.reshape(ML_HEADS, ML_HEAD_DIM)).reshape(B, S, ML_WIDTH).astype(x.dtype)
    y_ml = jax.nn.sigmoid(o_pre) * (hc + ml_skip * conv_act)
    x = x + jnp.concatenate([y_gm, y_ml], axis=-1) @ w_out
    hq = (_rmsnorm(x, g_xa) @ w_cq).reshape(B, S, XA_HEADS, XA_HEAD_DIM)
    sc = jnp.einsum('bshd,bmhd->bhsm', hq, mem_k.astype(hq.dtype)).astype(f32) * (XA_HEAD_DIM ** -0.5)
    p = jax.nn.softmax(sc, axis=-1).astype(x.dtype)
    att = jnp.einsum('bhsm,bmhd->bshd', p, mem_v.astype(x.dtype)).reshape(B, S, D_MODEL)
    x = x + att @ w_co
    hf = _rmsnorm(x, g_ffn)
    x = x + jnp.square(jax.nn.relu(hf @ w_up)) @ w_down
    new_buf = x_ext[:, -(ML_CONV - 1):]
    return x, v_gm, new_buf, C, n, m


def setup_inputs(seed: int = 0) -> dict:
    key = jax.random.key(seed)
    ks = iter(jax.random.split(key, 48))
    f32 = jnp.float32
    nrm = lambda shape, s: s * jax.random.normal(next(ks), shape, f32)
    gain = lambda shape: 1.0 + nrm(shape, 0.02)
    H, Dh = ML_HEADS, ML_HEAD_DIM
    return {
        "x_prompt": nrm((BATCH, SEQ, D_MODEL), 1.0),
        "x_sample": nrm((DEC_BATCH, DEC_SEQ, D_MODEL), 1.0),
        "mem_prompt": nrm((BATCH, MEM_TOKENS, D_MODEL), 1.0),
        "cache_mem_k": nrm((DEPTH, DEC_BATCH, MEM_TOKENS, XA_HEADS, XA_HEAD_DIM), 1.0),
        "cache_mem_v": nrm((DEPTH, DEC_BATCH, MEM_TOKENS, XA_HEADS, XA_HEAD_DIM), 1.0),
        "state_C": nrm((DEPTH, DEC_BATCH, H, Dh, Dh), 0.1),
        "state_n": nrm((DEPTH, DEC_BATCH, H, Dh), 0.1),
        "state_m": 2.0 + nrm((DEPTH, DEC_BATCH, H), 0.5),
        "state_conv": nrm((DEPTH, DEC_BATCH, ML_CONV - 1, ML_WIDTH), 1.0),
        "norm_mix_g": gain((DEPTH, D_MODEL)),
        "w_in": nrm((DEPTH, D_MODEL, N_IN), D_MODEL ** -0.5),
        "gm_v_norm_g": gain((DEPTH, GM_WIDTH)),
        "gm_ws": nrm((DEPTH, GM_HEADS, GM_CHUNK, GM_CHUNK), GM_CHUNK ** -0.5),
        "gm_bs": 1.0 + nrm((DEPTH, GM_HEADS, GM_CHUNK), 0.1),
        "ml_conv_w": nrm((DEPTH, ML_CONV, ML_WIDTH), 0.5),
        "ml_conv_b": nrm((DEPTH, ML_WIDTH), 0.01),
        "ml_wq": nrm((DEPTH, H, Dh, Dh), Dh ** -0.5),
        "ml_wk": nrm((DEPTH, H, Dh, Dh), Dh ** -0.5),
        "ml_wv": nrm((DEPTH, H, Dh, Dh), Dh ** -0.5),
        "ml_b_i": nrm((DEPTH, H), 0.1),
        "ml_b_f": jnp.linspace(3.0, 6.0, H, dtype=f32)[None, :] + nrm((DEPTH, H), 0.1),
        "ml_out_norm_g": gain((DEPTH, ML_WIDTH)),
        "ml_skip": 1.0 + nrm((DEPTH, ML_WIDTH), 0.1),
        "w_out": nrm((DEPTH, D_MIX, D_MODEL), D_MIX ** -0.5),
        "norm_mem_g": gain((DEPTH, D_MODEL)),
        "w_ck": nrm((DEPTH, D_MODEL, D_MODEL), D_MODEL ** -0.5),
        "w_cv": nrm((DEPTH, D_MODEL, D_MODEL), D_MODEL ** -0.5),
        "norm_xa_g": gain((DEPTH, D_MODEL)),
        "w_cq": nrm((DEPTH, D_MODEL, D_MODEL), D_MODEL ** -0.5),
        "w_co": nrm((DEPTH, D_MODEL, D_MODEL), D_MODEL ** -0.5),
        "norm_ffn_g": gain((DEPTH, D_MODEL)),
        "w_up": nrm((DEPTH, D_MODEL, D_FF), D_MODEL ** -0.5),
        "w_down": nrm((DEPTH, D_FF, D_MODEL), D_FF ** -0.5),
        "norm_f_g": gain((D_MODEL,)),
    }


def reference(x_prompt, x_sample, mem_prompt, cache_mem_k, cache_mem_v, state_C, state_n, state_m, state_conv,
              norm_mix_g, w_in, gm_v_norm_g, gm_ws, gm_bs, ml_conv_w, ml_conv_b, ml_wq, ml_wk, ml_wv,
              ml_b_i, ml_b_f, ml_out_norm_g, ml_skip, w_out, norm_mem_g, w_ck, w_cv, norm_xa_g, w_cq, w_co,
              norm_ffn_g, w_up, w_down, norm_f_g):
    f32 = jnp.float32
    B = x_prompt.shape[0]
    xp, xs = x_prompt, x_sample
    mk_p, mv_p, C_p, n_p, m_p, cv_p = [], [], [], [], [], []
    C_s, n_s, m_s, cv_s, gv_s = [], [], [], [], []
    for l in range(DEPTH):
        lw = (norm_mix_g[l], w_in[l], gm_v_norm_g[l], gm_ws[l], gm_bs[l], ml_conv_w[l], ml_conv_b[l],
              ml_wq[l], ml_wk[l], ml_wv[l], ml_b_i[l], ml_b_f[l], ml_out_norm_g[l], ml_skip[l], w_out[l],
              norm_xa_g[l], w_cq[l], w_co[l], norm_ffn_g[l], w_up[l], w_down[l])
        mk, mv = _mem_kv(mem_prompt, norm_mem_g[l], w_ck[l], w_cv[l])
        xp, _, bp, Cp, np_, mp = _layer(
            xp, mk, mv,
            jnp.zeros((B, ML_CONV - 1, ML_WIDTH), xp.dtype),
            jnp.zeros((B, ML_HEADS, ML_HEAD_DIM, ML_HEAD_DIM), f32),
            jnp.zeros((B, ML_HEADS, ML_HEAD_DIM), f32),
            jnp.zeros((B, ML_HEADS), f32), lw)
        mk_p.append(mk); mv_p.append(mv); C_p.append(Cp); n_p.append(np_); m_p.append(mp); cv_p.append(bp)
        xs, vs, bsm, Cs, ns, ms = _layer(
            xs, cache_mem_k[l], cache_mem_v[l], state_conv[l], state_C[l], state_n[l], state_m[l], lw)
        C_s.append(Cs); n_s.append(ns); m_s.append(ms); cv_s.append(bsm); gv_s.append(vs)
    y_prompt = _rmsnorm(xp, norm_f_g)
    y_sample = _rmsnorm(xs, norm_f_g)
    st = lambda a: jnp.stack(a, axis=0)
    return (y_prompt, y_sample, st(mk_p), st(mv_p), st(C_p), st(n_p), st(m_p), st(cv_p),
            st(C_s), st(n_s), st(m_s), st(cv_s), st(gv_s))
```

```cpp
#include <hip/hip_runtime.h>
#include <cstdio>
#include <cstdint>
namespace orc {
constexpr int D = 1024, NIN = 2056, GW = 512, MW = 512, FF = 4096, MEMT = 256;

__device__ __forceinline__ float block_sum(float v, float* red) {
    for (int o = 32; o > 0; o >>= 1) v += __shfl_xor(v, o);
    const int w = threadIdx.x >> 6, nw = blockDim.x >> 6;
    __syncthreads();
    if ((threadIdx.x & 63) == 0) red[w] = v;
    __syncthreads();
    float s = 0.f;
    for (int i = 0; i < nw; ++i) s += red[i];
    return s;
}
__device__ __forceinline__ float block_max(float v, float* red) {
    for (int o = 32; o > 0; o >>= 1) v = fmaxf(v, __shfl_xor(v, o));
    const int w = threadIdx.x >> 6, nw = blockDim.x >> 6;
    __syncthreads();
    if ((threadIdx.x & 63) == 0) red[w] = v;
    __syncthreads();
    float s = red[0];
    for (int i = 1; i < nw; ++i) s = fmaxf(s, red[i]);
    return s;
}
__global__ void k_rmsnorm(const float* x, int ldx, const float* g, float* y, int ldy, int Dn) {
    __shared__ float red[16];
    const float* xr = x + (size_t)blockIdx.x * ldx; float* yr = y + (size_t)blockIdx.x * ldy;
    float s = 0.f;
    for (int c = threadIdx.x; c < Dn; c += blockDim.x) { float v = xr[c]; s += v * v; }
    s = block_sum(s, red);
    const float r = rsqrtf(s / (float)Dn + 1e-6f);
    for (int c = threadIdx.x; c < Dn; c += blockDim.x) yr[c] = xr[c] * r * g[c];
}
struct GemmP { const float* A; const float* B; float* C; const float* R; int M, N, K, lda, ldb, ldc, transB, act, nzi; long sAo, sAi, sBo, sBi, sCo, sCi; float alpha; };
__global__ void __launch_bounds__(256) k_gemm(GemmP p) {
    __shared__ float As[16][68];
    __shared__ float Bs[16][68];
    const int z = blockIdx.z, zo = z / p.nzi, zi = z % p.nzi;
    const float* A = p.A + zo * p.sAo + zi * p.sAi; const float* B = p.B + zo * p.sBo + zi * p.sBi;
    float* C = p.C + zo * p.sCo + zi * p.sCi; const float* R = p.R ? p.R + zo * p.sCo + zi * p.sCi : nullptr;
    const int m0 = blockIdx.y * 64, n0 = blockIdx.x * 64, tid = threadIdx.x, tx = tid & 15, ty = tid >> 4;
    float acc[4][4];
#pragma unroll
    for (int i = 0; i < 4; ++i)
#pragma unroll
        for (int j = 0; j < 4; ++j) acc[i][j] = 0.f;
    for (int k0 = 0; k0 < p.K; k0 += 16) {
        { const int r = tid >> 2, kc = (tid & 3) * 4; float4 v = make_float4(0.f, 0.f, 0.f, 0.f);
          if (m0 + r < p.M) v = *(const float4*)(A + (size_t)(m0 + r) * p.lda + k0 + kc);
          As[kc + 0][r] = v.x; As[kc + 1][r] = v.y; As[kc + 2][r] = v.z; As[kc + 3][r] = v.w; }
        if (!p.transB) { const int kr = tid >> 4, c = (tid & 15) * 4; float4 v = make_float4(0.f, 0.f, 0.f, 0.f);
          if (n0 + c < p.N) v = *(const float4*)(B + (size_t)(k0 + kr) * p.ldb + n0 + c);
          Bs[kr][c + 0] = v.x; Bs[kr][c + 1] = v.y; Bs[kr][c + 2] = v.z; Bs[kr][c + 3] = v.w; }
        else { const int n = tid >> 2, kc = (tid & 3) * 4; float4 v = make_float4(0.f, 0.f, 0.f, 0.f);
          if (n0 + n < p.N) v = *(const float4*)(B + (size_t)(n0 + n) * p.ldb + k0 + kc);
          Bs[kc + 0][n] = v.x; Bs[kc + 1][n] = v.y; Bs[kc + 2][n] = v.z; Bs[kc + 3][n] = v.w; }
        __syncthreads();
#pragma unroll
        for (int k = 0; k < 16; ++k) {
            float a[4], b[4];
#pragma unroll
            for (int i = 0; i < 4; ++i) a[i] = As[k][ty * 4 + i];
#pragma unroll
            for (int j = 0; j < 4; ++j) b[j] = Bs[k][tx * 4 + j];
#pragma unroll
            for (int i = 0; i < 4; ++i)
#pragma unroll
                for (int j = 0; j < 4; ++j) acc[i][j] = fmaf(a[i], b[j], acc[i][j]);
        }
        __syncthreads();
    }
#pragma unroll
    for (int i = 0; i < 4; ++i) { const int r = m0 + ty * 4 + i; if (r >= p.M) continue;
#pragma unroll
        for (int j = 0; j < 4; ++j) { const int c = n0 + tx * 4 + j; if (c >= p.N) continue;
            float v = acc[i][j]; if (p.act == 1) { v = fmaxf(v, 0.f); v = v * v; }
            v *= p.alpha; if (R) v += R[(size_t)r * p.ldc + c];
            C[(size_t)r * p.ldc + c] = v; } }
}
static void gemm(hipStream_t st, const float* A, int lda, const float* B, int ldb, float* C, int ldc, int M, int N, int K,
                 const float* R = nullptr, int act = 0, float alpha = 1.f, int transB = 0,
                 int nzo = 1, int nzi = 1, long sAo = 0, long sAi = 0, long sBo = 0, long sBi = 0, long sCo = 0, long sCi = 0) {
    GemmP p{}; p.A = A; p.B = B; p.C = C; p.R = R; p.M = M; p.N = N; p.K = K; p.lda = lda; p.ldb = ldb; p.ldc = ldc; p.transB = transB; p.act = act; p.nzi = nzi;
    p.sAo = sAo; p.sAi = sAi; p.sBo = sBo; p.sBi = sBi; p.sCo = sCo; p.sCi = sCi; p.alpha = alpha;
    hipLaunchKernelGGL(k_gemm, dim3((N + 63) / 64, (M + 63) / 64, nzo * nzi), dim3(256), 0, st, p);
}
__device__ __forceinline__ float gelu_tanh(float x) { return 0.5f * x * (1.f + tanhf(0.7978845608028654f * (x + 0.044715f * x * x * x))); }
__global__ void k_gelu_split(const float* proj, float* U, float* V, int T) {
    const size_t i = (size_t)blockIdx.x * blockDim.x + threadIdx.x; if (i >= (size_t)T * 1024) return;
    const int r = (int)(i / 1024), c = (int)(i % 1024); const float v = gelu_tanh(proj[(size_t)r * NIN + c]);
    if (c < 512) U[(size_t)r * 512 + c] = v; else V[(size_t)r * 512 + c - 512] = v;
}
__global__ void k_gmlp_gate(const float* U, const float* Vn, const float* ws, const float* bs, float* ymix, int Bn, int S) {
    const size_t i = (size_t)blockIdx.x * blockDim.x + threadIdx.x; if (i >= (size_t)Bn * S * 512) return;
    const int c = (int)(i % 512); const size_t row = i / 512; const int t = (int)(row % S); const size_t b = row / S;
    const int h = c >> 7, tt = t & 127, t0 = t - tt;
    float acc = 0.f;
    for (int s = 0; s <= tt; ++s) acc += ws[((size_t)h * 128 + tt) * 128 + s] * Vn[(b * S + t0 + s) * 512 + c];
    acc += bs[h * 128 + tt];
    ymix[row * 1024 + c] = U[row * 512 + c] * acc;
}
__global__ void k_conv(const float* proj, const float* cbuf  , const float* cw, const float* cb, float* conv, float* newbuf, int Bn, int S) {
    const size_t i = (size_t)blockIdx.x * blockDim.x + threadIdx.x; if (i >= (size_t)Bn * S * 512) return;
    const int c = (int)(i % 512); const size_t row = i / 512; const int t = (int)(row % S); const size_t b = row / S;
    float a = cb[c];
#pragma unroll
    for (int j = 0; j < 4; ++j) { const int e = t + j; float xv;
        if (e < 3) xv = cbuf ? cbuf[(b * 3 + e) * 512 + c] : 0.f; else xv = proj[(b * S + e - 3) * NIN + 1024 + c];
        a += cw[j * 512 + c] * xv; }
    conv[row * 512 + c] = a / (1.f + expf(-a));
    if (t == 0) { for (int r = 0; r < 3; ++r) { const int e = S + r; float xv;
        if (e < 3) xv = cbuf ? cbuf[(b * 3 + e) * 512 + c] : 0.f; else xv = proj[(b * S + e - 3) * NIN + 1024 + c];
        newbuf[(b * 3 + r) * 512 + c] = xv; } }
}
__global__ void k_copy_cols(const float* src, int lds_, int c0, float* dst, int ldd, int T, int ncol) {
    const size_t i = (size_t)blockIdx.x * blockDim.x + threadIdx.x; if (i >= (size_t)T * ncol) return;
    const int c = (int)(i % ncol); const size_t r = i / ncol; dst[r * ldd + c] = src[r * lds_ + c0 + c];
}
__global__ void k_gates(const float* proj, const float* bi, const float* bf, float* IG, float* LF, int T) {
    const int i = blockIdx.x * blockDim.x + threadIdx.x; if (i >= T * 4) return;
    const int h = i & 3, r = i >> 2; IG[i] = proj[(size_t)r * NIN + 2048 + h] + bi[h];
    const float z = proj[(size_t)r * NIN + 2052 + h] + bf[h];
    LF[i] = fminf(z, 0.f) - log1pf(expf(-fabsf(z)));
}
__global__ void __launch_bounds__(128) k_mlstm_seq(const float* q, const float* k, const float* v, const float* IG, const float* LF,
        const float* C0, const float* n0, const float* m0, float* hc, float* Cout, float* nout, float* mout, int S) {
    __shared__ float qs[128], ks[128], red[4];
    const int bh = blockIdx.x, b = bh >> 2, h = bh & 3, j = threadIdx.x;
    float Cc[128];
#pragma unroll
    for (int kk = 0; kk < 128; ++kk) Cc[kk] = C0 ? C0[((size_t)bh * 128 + kk) * 128 + j] : 0.f;
    float nj = n0 ? n0[bh * 128 + j] : 0.f; float m = m0 ? m0[bh] : 0.f;
    for (int t = 0; t < S; ++t) {
        const size_t row = (size_t)b * S + t;
        __syncthreads();
        qs[j] = q[row * 512 + h * 128 + j]; ks[j] = k[row * 512 + h * 128 + j];
        const float vj = v[row * 512 + h * 128 + j]; const float ig = IG[row * 4 + h], lf = LF[row * 4 + h];
        __syncthreads();
        const float mn = fmaxf(lf + m, ig), fd = expf(lf + m - mn), iw = expf(ig - mn);
        float num = 0.f; const float ivj = iw * vj;
#pragma unroll
        for (int kk = 0; kk < 128; ++kk) { Cc[kk] = fmaf(fd, Cc[kk], ks[kk] * ivj); num = fmaf(qs[kk], Cc[kk], num); }
        nj = fd * nj + iw * ks[j];
        float dp = qs[j] * nj;
        for (int o = 32; o > 0; o >>= 1) dp += __shfl_xor(dp, o);
        if ((j & 63) == 0) red[j >> 6] = dp;
        __syncthreads();
        const float den = red[0] + red[1];
        hc[row * 512 + h * 128 + j] = num / fmaxf(fabsf(den), expf(-mn));
        m = mn;
    }
#pragma unroll
    for (int kk = 0; kk < 128; ++kk) Cout[((size_t)bh * 128 + kk) * 128 + j] = Cc[kk];
    nout[bh * 128 + j] = nj; if (j == 0) mout[bh] = m;
}
__global__ void __launch_bounds__(512) k_ml_out(const float* hc, const float* proj, const float* conv, const float* og, const float* skip, float* ymix) {
    __shared__ float red[8];
    const size_t row = blockIdx.x; const int c = threadIdx.x, w = c >> 6;
    const float v = hc[row * 512 + c]; float s = v * v;
    for (int o = 32; o > 0; o >>= 1) s += __shfl_xor(s, o);
    if ((c & 63) == 0) red[w] = s;
    __syncthreads();
    const float tot = red[(c >> 7) * 2] + red[(c >> 7) * 2 + 1];
    const float hn = v * rsqrtf(tot / 128.f + 1e-6f) * og[c];
    const float o = proj[row * NIN + 1536 + c];
    ymix[row * 1024 + 512 + c] = (1.f / (1.f + expf(-o))) * (hn + skip[c] * conv[row * 512 + c]);
}
__global__ void __launch_bounds__(256) k_softmax256(float* sc, float scale) {
    __shared__ float red[4];
    float* r = sc + (size_t)blockIdx.x * 256; const float v = r[threadIdx.x] * scale;
    const float mx = block_max(v, red); const float e = expf(v - mx); const float s = block_sum(e, red);
    r[threadIdx.x] = e / s;
}

struct Bufs {
    float *X, *H, *PROJ, *U, *V, *CONV, *XM, *Q, *K, *VV, *HC, *YMIX, *IG, *LF, *SC, *ATT, *HMID;
};
struct Weights { const float *g_mix, *w_in, *gm_vg, *gm_ws, *gm_bs, *cw, *cb, *wq, *wk, *wv, *bi, *bf, *og, *skip, *w_out, *g_xa, *w_cq, *w_co, *g_ffn, *w_up, *w_down; };
#define EW(n) dim3((unsigned)(((size_t)(n) + 255) / 256)), dim3(256), 0, st
static void layer(hipStream_t st, const Bufs& bf, const Weights& w, int Bn, int S, const float* memk, const float* memv,
                  const float* cbuf, const float* C0, const float* n0, const float* m0,
                  float* Cout, float* nout, float* mout, float* convout, float* gvout) {
    const int T = Bn * S;
    hipLaunchKernelGGL(k_rmsnorm, dim3(T), dim3(256), 0, st, bf.X, D, w.g_mix, bf.H, D, D);
    gemm(st, bf.H, D, w.w_in, NIN, bf.PROJ, NIN, T, NIN, D);
    hipLaunchKernelGGL(k_gelu_split, EW((size_t)T * 1024), bf.PROJ, bf.U, bf.V, T);
    float* vn = gvout ? gvout : bf.V;
    hipLaunchKernelGGL(k_rmsnorm, dim3(T), dim3(256), 0, st, bf.V, GW, w.gm_vg, vn, GW, GW);
    hipLaunchKernelGGL(k_gmlp_gate, EW((size_t)T * 512), bf.U, vn, w.gm_ws, w.gm_bs, bf.YMIX, Bn, S);
    hipLaunchKernelGGL(k_conv, EW((size_t)T * 512), bf.PROJ, cbuf, w.cw, w.cb, bf.CONV, convout, Bn, S);
    hipLaunchKernelGGL(k_copy_cols, EW((size_t)T * 512), bf.PROJ, NIN, 1024, bf.XM, 512, T, 512);
    gemm(st, bf.CONV, 512, w.wq, 128, bf.Q, 512, T, 128, 128, nullptr, 0, 1.f, 0, 1, 4, 0, 128, 0, 128 * 128, 0, 128);
    gemm(st, bf.CONV, 512, w.wk, 128, bf.K, 512, T, 128, 128, nullptr, 0, 0.08838834764831845f, 0, 1, 4, 0, 128, 0, 128 * 128, 0, 128);
    gemm(st, bf.XM, 512, w.wv, 128, bf.VV, 512, T, 128, 128, nullptr, 0, 1.f, 0, 1, 4, 0, 128, 0, 128 * 128, 0, 128);
    hipLaunchKernelGGL(k_gates, EW(T * 4), bf.PROJ, w.bi, w.bf, bf.IG, bf.LF, T);
    hipLaunchKernelGGL(k_mlstm_seq, dim3(Bn * 4), dim3(128), 0, st, bf.Q, bf.K, bf.VV, bf.IG, bf.LF, C0, n0, m0, bf.HC, Cout, nout, mout, S);
    hipLaunchKernelGGL(k_ml_out, dim3(T), dim3(512), 0, st, bf.HC, bf.PROJ, bf.CONV, w.og, w.skip, bf.YMIX);
    gemm(st, bf.YMIX, D, w.w_out, D, bf.X, D, T, D, D, bf.X);
    hipLaunchKernelGGL(k_rmsnorm, dim3(T), dim3(256), 0, st, bf.X, D, w.g_xa, bf.H, D, D);
    gemm(st, bf.H, D, w.w_cq, D, bf.PROJ, D, T, D, D);
    gemm(st, bf.PROJ, D, memk, D, bf.SC, 256, S, 256, 256, nullptr, 0, 1.f, 1, Bn, 4, (long)S * D, 256, (long)MEMT * D, 256, (long)4 * S * 256, (long)S * 256);
    hipLaunchKernelGGL(k_softmax256, dim3(Bn * 4 * S), dim3(256), 0, st, bf.SC, 0.0625f);
    gemm(st, bf.SC, 256, memv, D, bf.ATT, D, S, 256, 256, nullptr, 0, 1.f, 0, Bn, 4, (long)4 * S * 256, (long)S * 256, (long)MEMT * D, 256, (long)S * D, 256);
    gemm(st, bf.ATT, D, w.w_co, D, bf.X, D, T, D, D, bf.X);
    hipLaunchKernelGGL(k_rmsnorm, dim3(T), dim3(256), 0, st, bf.X, D, w.g_ffn, bf.H, D, D);
    for (int r0 = 0; r0 < T; r0 += 4096) { const int rows = (T - r0) < 4096 ? (T - r0) : 4096;
        gemm(st, bf.H + (size_t)r0 * D, D, w.w_up, FF, bf.HMID, FF, rows, FF, D, nullptr, 1);
        gemm(st, bf.HMID, FF, w.w_down, D, bf.X + (size_t)r0 * D, D, rows, D, FF, bf.X + (size_t)r0 * D); }
}
}
namespace orc {
constexpr size_t O_YP = 0, O_YS = 16777216, O_MK = 16908288, O_MV = 21102592, O_CP = 25296896, O_NP = 26345472, O_MP = 26353664, O_CVP = 26353728,
                 O_CS = 26378304, O_NS = 43155520, O_MS = 43286592, O_CVS = 43287616, O_GV = 43680832, O_END = 43811904;
static Weights layer_weights(void* const* d_in, int l) {
    auto in = [&](int i) { return (const float*)d_in[i]; };
    Weights w;
    w.g_mix = in(9) + (size_t)l * 1024; w.w_in = in(10) + (size_t)l * 1024 * NIN; w.gm_vg = in(11) + (size_t)l * 512; w.gm_ws = in(12) + (size_t)l * 65536; w.gm_bs = in(13) + (size_t)l * 512;
    w.cw = in(14) + (size_t)l * 2048; w.cb = in(15) + (size_t)l * 512; w.wq = in(16) + (size_t)l * 65536; w.wk = in(17) + (size_t)l * 65536; w.wv = in(18) + (size_t)l * 65536;
    w.bi = in(19) + (size_t)l * 4; w.bf = in(20) + (size_t)l * 4; w.og = in(21) + (size_t)l * 512; w.skip = in(22) + (size_t)l * 512; w.w_out = in(23) + (size_t)l * 1048576;
    w.g_xa = in(27) + (size_t)l * 1024; w.w_cq = in(28) + (size_t)l * 1048576; w.w_co = in(29) + (size_t)l * 1048576; w.g_ffn = in(30) + (size_t)l * 1024;
    w.w_up = in(31) + (size_t)l * 4194304; w.w_down = in(32) + (size_t)l * 4194304;
    return w;
}
static Bufs carve(float* base) {
    Bufs b; size_t o = 0; const size_t T = 16384;
    b.X = base + o; o += T * 1024; b.H = base + o; o += T * 1024; b.PROJ = base + o; o += T * NIN;
    b.U = base + o; o += T * 512; b.V = base + o; o += T * 512; b.CONV = base + o; o += T * 512; b.XM = base + o; o += T * 512;
    b.Q = base + o; o += T * 512; b.K = base + o; o += T * 512; b.VV = base + o; o += T * 512; b.HC = base + o; o += T * 512;
    b.YMIX = base + o; o += T * 1024; b.IG = base + o; o += T * 4; b.LF = base + o; o += T * 4;
    b.SC = b.U; b.ATT = b.CONV; b.HMID = b.Q;
    return b;
}
static void run_all(hipStream_t st, void* const* d_in, float* out, float* base) {
    auto in = [&](int i) { return (const float*)d_in[i]; };
    const Bufs bf = carve(base);
    hipMemcpyAsync(bf.X, in(0), (size_t)16384 * 1024 * 4, hipMemcpyDeviceToDevice, st);
    for (int l = 0; l < 2; ++l) {
        const Weights w = layer_weights(d_in, l);
        float* mk = out + O_MK + (size_t)l * 2097152; float* mv = out + O_MV + (size_t)l * 2097152;
        hipLaunchKernelGGL(k_rmsnorm, dim3(2048), dim3(256), 0, st, in(2), D, in(24) + (size_t)l * 1024, bf.H, D, D);
        gemm(st, bf.H, D, in(25) + (size_t)l * 1048576, D, mk, D, 2048, D, D);
        gemm(st, bf.H, D, in(26) + (size_t)l * 1048576, D, mv, D, 2048, D, D);
        layer(st, bf, w, 8, 2048, mk, mv, nullptr, nullptr, nullptr, nullptr,
              out + O_CP + (size_t)l * 524288, out + O_NP + (size_t)l * 4096, out + O_MP + (size_t)l * 32, out + O_CVP + (size_t)l * 12288, nullptr);
    }
    hipLaunchKernelGGL(k_rmsnorm, dim3(16384), dim3(256), 0, st, bf.X, D, in(33), out + O_YP, D, D);
    hipMemcpyAsync(bf.X, in(1), (size_t)128 * 1024 * 4, hipMemcpyDeviceToDevice, st);
    for (int l = 0; l < 2; ++l) {
        const Weights w = layer_weights(d_in, l);
        layer(st, bf, w, 128, 1, in(3) + (size_t)l * 33554432, in(4) + (size_t)l * 33554432, in(8) + (size_t)l * 196608,
              in(5) + (size_t)l * 8388608, in(6) + (size_t)l * 65536, in(7) + (size_t)l * 512,
              out + O_CS + (size_t)l * 8388608, out + O_NS + (size_t)l * 65536, out + O_MS + (size_t)l * 512, out + O_CVS + (size_t)l * 196608, out + O_GV + (size_t)l * 65536);
    }
    hipLaunchKernelGGL(k_rmsnorm, dim3(128), dim3(256), 0, st, bf.X, D, in(33), out + O_YS, D, D);
}
}
extern "C" void kernel_launch(void* const* d_in, const int* in_sizes, int n_in, void* d_out, int out_size, void* d_ws, size_t ws_size, hipStream_t stream) {
    orc::run_all(stream, d_in, (float*)d_out, (float*)d_ws);
}
```

```cpp
#include <hip/hip_runtime.h>
#include <cstdio>
#include <cstdint>
namespace pg8 {
#define PG8_LAS __attribute__((address_space(3)))
typedef unsigned short bf16_t;
typedef short bf16x8 __attribute__((ext_vector_type(8)));
typedef float f32x4 __attribute__((ext_vector_type(4)));
typedef unsigned u32x4 __attribute__((ext_vector_type(4)));
constexpr int BM = 256, BK = 64, HALF = 128, HTB = HALF * BK * 2  , STAGE_BYTES = 8 * HTB, NXCD = 8, WGM = 8;

__host__ __device__ __forceinline__ int lds_byte(int r, int c) { const int st = (r >> 4) * 2 + (c >> 5), rr = r & 15, cc = c & 31, ob = rr * 64 + cc * 2; return st * 1024 + (ob ^ (((ob >> 9) & 1) << 5)); }
__host__ __device__ __forceinline__ void stage_rc(int b, int& R, int& C) { const int st = b / 1024, sb = b % 1024, swz = sb ^ (((sb >> 9) & 1) << 5); R = (st >> 1) * 16 + swz / 64; C = (st & 1) * 32 + (swz % 64) / 2; }
__host__ __device__ __forceinline__ int perm32(int rho) { const int n = rho >> 4, i = rho & 15; return 8 * (i >> 2) + 4 * n + (i & 3); }

struct Unit { int pm, pn; };
struct Gemm { const bf16_t* A; const bf16_t* Bt; int M, N, K; };

struct StaticOrder {
    int nM, nN, nwg, G, c;
    __host__ __device__ void init(int M, int N, int G_, int c_) { nM = M / BM; nN = N / BM; nwg = nM * nN; G = G_; c = c_; }
    __host__ __device__ bool next(int i, Unit& u) const {
        const long L = (long)i * G + c; if (L >= nwg) return false;
        int wgid = (int)L; { const int q = nwg / NXCD, r = nwg % NXCD, xcd = wgid % NXCD, off = wgid / NXCD; wgid = (xcd < r ? xcd * (q + 1) : r * (q + 1) + (xcd - r) * q) + off; }
        const int nig = WGM * nN, gid = wgid / nig, fm = gid * WGM, gsz = (nM - fm) < WGM ? (nM - fm) : WGM;
        u.pm = fm + ((wgid % nig) % gsz); u.pn = (wgid % nig) / gsz; return true;
    }
    __device__ __forceinline__ void a_ready(const Unit&) const {}
    __device__ __forceinline__ void done(const Unit&) const {}
};

__device__ __forceinline__ unsigned cvt_pk_bf16(float lo, float hi) { unsigned r; asm volatile("v_cvt_pk_bf16_f32 %0, %1, %2" : "=v"(r) : "v"(lo), "v"(hi)); return r; }
template <class Epi, class Sched, bool ALIGN_EPI = false, bool SP2 = false>
__device__ __forceinline__ void gemm_phase(PG8_LAS unsigned char* lds, const Gemm g, const Sched& S, const Epi& E, int wave_in) {
    int lane_o; asm volatile("v_mbcnt_lo_u32_b32 %0, -1, 0\n\tv_mbcnt_hi_u32_b32 %0, -1, %0" : "=v"(lane_o));
    const int wid = __builtin_amdgcn_readfirstlane(wave_in), lane = lane_o, tid = wid * 64 + lane, wr = wid >> 2, wc = wid & 3, fr = lane & 15, fq = lane >> 4;
    const int K = g.K, nt = K / BK;
    unsigned voffA[2], voffB[2];
#pragma unroll
    for (int i = 0; i < 2; ++i) { int R, C; stage_rc(tid * 16 + i * 8192, R, C); const int Rb = Epi::PERM ? ((R & ~31) + perm32(R & 31)) : R;
        voffA[i] = (unsigned)(R * K + C) * 2u; voffB[i] = (unsigned)(Rb * K + C) * 2u; }
    const size_t kstep = (size_t)(BK * 2);
    const size_t hstep = (size_t)HALF * K * 2;
    const size_t tstep = 2 * hstep;
    const unsigned ldsw = (unsigned)wid * 1024u;
    const int aoff = lds_byte(wr * 64 + fr, fq * 8), boff = lds_byte(wc * 32 + fr, fq * 8);
#define PG8_SA(b, h) (((b) * 2 + (h)) * HTB)
#define PG8_SB(b, h) ((4 + (b) * 2 + (h)) * HTB)
#define PG8_STAGE(bufoff, gbase, voff) do { _Pragma("unroll") for (int _i = 0; _i < 2; ++_i) \
        __builtin_amdgcn_global_load_lds((const unsigned*)((const char*)(gbase) + (voff)[_i]), (PG8_LAS unsigned*)(lds + (bufoff) + ldsw + _i * 8192), 16, 0, 0); } while (0)
#define PG8_LDA(dst, b, h) do { _Pragma("unroll") for (int m = 0; m < 4; ++m) _Pragma("unroll") for (int k = 0; k < 2; ++k) dst[m][k] = *(const PG8_LAS bf16x8*)(lds + PG8_SA(b, h) + aoff + m * 2048 + k * 1024); } while (0)
#define PG8_LDB(dst, b, h) do { _Pragma("unroll") for (int n = 0; n < 2; ++n) _Pragma("unroll") for (int k = 0; k < 2; ++k) dst[n][k] = *(const PG8_LAS bf16x8*)(lds + PG8_SB(b, h) + boff + n * 2048 + k * 1024); } while (0)
#define PG8_MMA(ai, bj, At, Bt) do { __builtin_amdgcn_s_setprio(1); _Pragma("unroll") for (int m = 0; m < 4; ++m) _Pragma("unroll") for (int n = 0; n < 2; ++n) _Pragma("unroll") for (int k = 0; k < 2; ++k) \
        acc[ai][bj][m][n] = __builtin_amdgcn_mfma_f32_16x16x32_bf16(Bt[n][k], At[m][k], acc[ai][bj][m][n], 0, 0, 0); __builtin_amdgcn_s_setprio(0); } while (0)
#define PG8_WAIT_V(n) asm volatile("s_waitcnt vmcnt(" #n ")" ::: "memory")
#define PG8_WAIT_L(n) asm volatile("s_waitcnt lgkmcnt(" #n ")" ::: "memory")
#define PG8_BAR __builtin_amdgcn_s_barrier()
#define PG8_SCHED __builtin_amdgcn_sched_barrier(0)
    Unit cur, nxt; int ui = 0;
    if (!S.next(0, cur)) return;
    f32x4 acc[2][2][4][2];
#pragma unroll
    for (int a = 0; a < 2; ++a)
#pragma unroll
        for (int b = 0; b < 2; ++b)
#pragma unroll
            for (int m = 0; m < 4; ++m)
#pragma unroll
                for (int n = 0; n < 2; ++n) acc[a][b][m][n] = (f32x4){0.f, 0.f, 0.f, 0.f};
    bf16x8 At[4][2], B0[2][2], B1[2][2];
    const char* cA = (const char*)g.A + (size_t)cur.pm * tstep; const char* cB = (const char*)g.Bt + (size_t)cur.pn * tstep;
    S.a_ready(cur);
    if constexpr (SP2) {
        PG8_STAGE(PG8_SB(0, 0), cB, voffB); PG8_STAGE(PG8_SB(0, 1), cB + hstep, voffB); PG8_STAGE(PG8_SA(0, 0), cA, voffA); PG8_STAGE(PG8_SA(0, 1), cA + hstep, voffA);
        if (wr == 1) PG8_BAR;
        PG8_WAIT_V(2); PG8_BAR;
        PG8_STAGE(PG8_SB(1, 0), cB + kstep, voffB); PG8_STAGE(PG8_SA(1, 0), cA + kstep, voffA); PG8_STAGE(PG8_SB(1, 1), cB + hstep + kstep, voffB);
        PG8_WAIT_V(6); PG8_BAR;
    } else {
        PG8_STAGE(PG8_SB(0, 0), cB, voffB); PG8_STAGE(PG8_SA(0, 0), cA, voffA); PG8_STAGE(PG8_SB(0, 1), cB + hstep, voffB); PG8_STAGE(PG8_SA(0, 1), cA + hstep, voffA);
        if (wr == 1) PG8_BAR;
        PG8_WAIT_V(4); PG8_BAR;
        PG8_STAGE(PG8_SB(1, 0), cB + kstep, voffB); PG8_STAGE(PG8_SA(1, 0), cA + kstep, voffA); PG8_STAGE(PG8_SB(1, 1), cB + hstep + kstep, voffB);
        PG8_WAIT_V(6); PG8_BAR;
    }
    for (;;) {
        const bool has_next = S.next(ui + 1, nxt);
        const char* nA = has_next ? (const char*)g.A + (size_t)nxt.pm * tstep : cA; const char* nB = has_next ? (const char*)g.Bt + (size_t)nxt.pn * tstep : cB;
        for (int t = 0; t < nt; t += 2) {
            const bool last = (t == nt - 2);
            const char* a1 = cA + (size_t)(t + 1) * kstep;
            const char* a2 = last ? nA : cA + (size_t)(t + 2) * kstep; const char* b2 = last ? nB : cB + (size_t)(t + 2) * kstep;
            const char* a3 = a2 + kstep; const char* b3 = b2 + kstep;
            if (last && has_next) S.a_ready(nxt);
            if constexpr (SP2) {
            PG8_LDB(B0, 0, 0); PG8_LDB(B1, 0, 1); PG8_SCHED; PG8_LDA(At, 0, 0); PG8_STAGE(PG8_SA(1, 1), a1 + hstep, voffA);
            PG8_WAIT_V(8); PG8_WAIT_L(0); PG8_BAR; PG8_MMA(0, 0, At, B0); PG8_MMA(0, 1, At, B1); PG8_BAR; PG8_SCHED;
            PG8_LDA(At, 0, 1); PG8_STAGE(PG8_SB(0, 0), b2, voffB); PG8_STAGE(PG8_SB(0, 1), b2 + hstep, voffB); PG8_STAGE(PG8_SA(0, 0), a2, voffA);
            PG8_WAIT_V(8); PG8_WAIT_L(0); PG8_BAR; PG8_MMA(1, 0, At, B0); PG8_MMA(1, 1, At, B1); PG8_BAR; PG8_SCHED;
            PG8_LDB(B0, 1, 0); PG8_LDB(B1, 1, 1); PG8_SCHED; PG8_LDA(At, 1, 0); PG8_STAGE(PG8_SA(0, 1), a2 + hstep, voffA);
            PG8_WAIT_V(8); PG8_WAIT_L(0); PG8_BAR; PG8_MMA(0, 0, At, B0); PG8_MMA(0, 1, At, B1); PG8_BAR; PG8_SCHED;
            PG8_LDA(At, 1, 1); PG8_STAGE(PG8_SB(1, 0), b3, voffB); PG8_STAGE(PG8_SB(1, 1), b3 + hstep, voffB); PG8_STAGE(PG8_SA(1, 0), a3, voffA);
            PG8_WAIT_V(8); PG8_WAIT_L(0); PG8_BAR; PG8_MMA(1, 0, At, B0); PG8_MMA(1, 1, At, B1); PG8_BAR; PG8_SCHED;
            } else {
            PG8_LDB(B0, 0, 0); PG8_SCHED; PG8_LDA(At, 0, 0); PG8_STAGE(PG8_SA(1, 1), a1 + hstep, voffA);
            PG8_WAIT_L(8); PG8_BAR; PG8_WAIT_L(0); PG8_MMA(0, 0, At, B0); PG8_BAR; PG8_SCHED;
            PG8_LDB(B1, 0, 1); PG8_STAGE(PG8_SB(0, 0), b2, voffB);
            PG8_BAR; PG8_WAIT_L(0); PG8_MMA(0, 1, At, B1); PG8_BAR;
            PG8_LDA(At, 0, 1); PG8_STAGE(PG8_SA(0, 0), a2, voffA);
            PG8_BAR; PG8_WAIT_L(0); PG8_MMA(1, 0, At, B0); PG8_BAR; PG8_SCHED;
            PG8_STAGE(PG8_SB(0, 1), b2 + hstep, voffB);
            PG8_WAIT_V(6); PG8_BAR; PG8_MMA(1, 1, At, B1); PG8_BAR;
            PG8_LDB(B0, 1, 0); PG8_SCHED; PG8_LDA(At, 1, 0); PG8_STAGE(PG8_SA(0, 1), a2 + hstep, voffA);
            PG8_WAIT_L(8); PG8_BAR; PG8_WAIT_L(0); PG8_MMA(0, 0, At, B0); PG8_BAR; PG8_SCHED;
            PG8_LDB(B1, 1, 1); PG8_STAGE(PG8_SB(1, 0), b3, voffB);
            PG8_BAR; PG8_WAIT_L(0); PG8_MMA(0, 1, At, B1); PG8_BAR;
            PG8_LDA(At, 1, 1); PG8_STAGE(PG8_SA(1, 0), a3, voffA);
            PG8_BAR; PG8_WAIT_L(0); PG8_MMA(1, 0, At, B0); PG8_BAR; PG8_SCHED;
            PG8_STAGE(PG8_SB(1, 1), b3 + hstep, voffB);
            PG8_WAIT_V(6); PG8_BAR; PG8_MMA(1, 1, At, B1); PG8_BAR;
            }
        }
        if constexpr (ALIGN_EPI) { if (wr == 0) PG8_BAR; }
        if constexpr (!Epi::AFTER_DRAIN) { E(acc, cur, wr, wc, fr, fq); S.done(cur); }
        if (!has_next) break;
#pragma unroll
        for (int a = 0; a < 2; ++a)
#pragma unroll
            for (int b = 0; b < 2; ++b)
#pragma unroll
                for (int m = 0; m < 4; ++m)
#pragma unroll
                    for (int n = 0; n < 2; ++n) acc[a][b][m][n] = (f32x4){0.f, 0.f, 0.f, 0.f};
        cur = nxt; cA = nA; cB = nB; ++ui;
        if constexpr (ALIGN_EPI) { if (wr == 1) PG8_BAR; }
    }
    PG8_WAIT_V(0);
    if constexpr (!ALIGN_EPI) { if (wr == 0) PG8_BAR; }
    PG8_BAR;
    if constexpr (Epi::AFTER_DRAIN) { E.fused(acc, cur, wr, wc, fr, fq, lds, wid, lane); S.done(cur); }
#undef PG8_SA
#undef PG8_SB
#undef PG8_STAGE
#undef PG8_LDA
#undef PG8_LDB
#undef PG8_MMA
#undef PG8_WAIT_V
#undef PG8_WAIT_L
#undef PG8_BAR
#undef PG8_SCHED
}
}
namespace fk {
#define GAS __attribute__((address_space(1)))
#define LAS __attribute__((address_space(3)))
typedef unsigned short bf16;
typedef unsigned v4u __attribute__((ext_vector_type(4)));
typedef unsigned v2u __attribute__((ext_vector_type(2)));
typedef float f32x4 __attribute__((ext_vector_type(4)));
typedef float f32x2 __attribute__((ext_vector_type(2)));
typedef short bf16x8 __attribute__((ext_vector_type(8)));
typedef short bf16x4 __attribute__((ext_vector_type(4)));
#define LDS_WAIT() asm volatile("s_waitcnt lgkmcnt(0)" ::: "memory")
#define VM_WAIT() asm volatile("s_waitcnt vmcnt(0)" ::: "memory")

constexpr int NWAVES = 8, NTHR = 512;
constexpr int M = 16384, MS = 128, MT = M + MS, D = 1024, FF = 4096, NIN = 2056, SEQ = 2048, NB = 8;
constexpr float EPS = 1e-6f;
constexpr size_t O_YP = 0, O_YS = 16777216, O_MK = 16908288, O_MV = 21102592, O_CP = 25296896, O_NP = 26345472, O_MP = 26353664, O_CVP = 26353728,
                 O_CS = 26378304, O_NS = 43155520, O_MS = 43286592, O_CVS = 43287616, O_GV = 43680832, O_END = 43811904;
constexpr size_t MiB = 1u << 20;
constexpr size_t WS_CTL = 0, CTL_BYTES = 1 * MiB;
constexpr size_t WS_WG = 1 * MiB;
constexpr size_t WS_HW = 2 * MiB;
constexpr size_t WS_WIN = 4 * MiB, WS_WOUT = 12 * MiB, WS_WCQ = 16 * MiB, WS_WCO = 20 * MiB, WS_WUP = 24 * MiB, WS_WDOWN = 40 * MiB, WS_WMEM = 56 * MiB;
constexpr size_t WS_MB = 64 * MiB, WS_SSQM = 68 * MiB, WS_KB = 70 * MiB, WS_VTB = 78 * MiB;
constexpr size_t WS_XB = 86 * MiB, WS_X = 119 * MiB, WS_SSQ = 184 * MiB, WS_SSQV = 186 * MiB, WS_GATES = 187 * MiB, WS_BT = 188 * MiB, WS_UNITS = 189 * MiB;
constexpr size_t WS_U = 190 * MiB, WS_VG = 206 * MiB, WS_XM = 222 * MiB, WS_OP = 238 * MiB, WS_Q = 254 * MiB, WS_KP = 270 * MiB, WS_CONV = 286 * MiB, WS_VT = 302 * MiB;
constexpr size_t WS_UEXT = 318 * MiB, WS_YMIX = 354 * MiB, WS_QA = 386 * MiB, WS_ATT = 418 * MiB, WS_HMID = 190 * MiB;
constexpr size_t WS_SAMP = 450 * MiB, WS_FAST_END = 470 * MiB;
constexpr int CW_TMO = 0, CW_BAR = 4096;
constexpr int RING_BYTES = 131072, LDS_BYTES = 155648  , MISC_OFF = 155648 - 256;

__device__ __forceinline__ unsigned f2bf(float f) { unsigned u = __builtin_bit_cast(unsigned, f); return (u + 0x7fffu + ((u >> 16) & 1u)) >> 16; }
__device__ __forceinline__ unsigned pk2(float lo, float hi) { return f2bf(lo) | (f2bf(hi) << 16); }
typedef float f32x2_t __attribute__((ext_vector_type(2)));
typedef __bf16 bf16x2_t __attribute__((ext_vector_type(2)));
__device__ __forceinline__ unsigned cvtpk(float lo, float hi) { f32x2_t v = {lo, hi}; bf16x2_t b = __builtin_convertvector(v, bf16x2_t); return __builtin_bit_cast(unsigned, b); }
__device__ __forceinline__ int lane_id_asm() { int l; asm volatile("v_mbcnt_lo_u32_b32 %0, -1, 0\n\tv_mbcnt_hi_u32_b32 %0, -1, %0" : "=v"(l)); return l; }
__device__ __forceinline__ float bf2f(unsigned short b) { return __builtin_bit_cast(float, (unsigned)b << 16); }
__device__ __forceinline__ float wave_sum(float v) {
#pragma unroll
    for (int o = 1; o < 64; o <<= 1) v += __shfl_xor(v, o);
    return v;
}
__device__ __forceinline__ float gelu_f(float x) { const float y = 0.7978845608028654f * (x + 0.044715f * x * x * x); return x * __builtin_amdgcn_rcpf(1.f + __expf(-2.f * y)); }

#define XB_TMO      128
#define XB_XCNT(j)  (256  + 64 * (j))
#define XB_XSUB(j)  (1280 + 64 * (j))
#define XB_XGEN(j)  (2304 + 64 * (j))
#define XB_TOP      3328
#define XB_TOPGEN   3392
#define XCD_BAR_WORDS 3456
#define XB_SPIN_CAP (1u << 20)
__device__ __forceinline__ unsigned xb_ld(unsigned* p)              { return __hip_atomic_load(p, __ATOMIC_RELAXED, __HIP_MEMORY_SCOPE_AGENT); }
__device__ __forceinline__ unsigned xb_add(unsigned* p, unsigned v) { return __hip_atomic_fetch_add(p, v, __ATOMIC_RELAXED, __HIP_MEMORY_SCOPE_AGENT); }
__device__ __forceinline__ unsigned xb_xcc_id() { return (unsigned)__builtin_amdgcn_s_getreg((3 << 11) | 20) & 0xFu; }
#define XB_SPIN(cond, bar) do { unsigned _sp = 0; while (cond) { __builtin_amdgcn_s_sleep(1); \
    if ((++_sp & 255u) == 0u) { if (xb_ld(&(bar)[XB_TMO])) break; if (_sp > XB_SPIN_CAP) { atomicAdd(&(bar)[XB_TMO], 1u); break; } } } } while (0)
struct XcdBarrier { unsigned* bar; unsigned x; volatile LAS unsigned* st; };
__device__ __forceinline__ XcdBarrier xcd_barrier_post(unsigned* bar, volatile LAS unsigned* st) {
    XcdBarrier b; b.bar = bar; b.x = xb_xcc_id(); b.st = st;
    if (threadIdx.x == 0) (void)xb_add(&bar[XB_XCNT(b.x)], 1u);
    return b;
}
__device__ __forceinline__ void xcd_barrier_complete(unsigned* bar, unsigned x, unsigned& nloc, unsigned& nx) {
    const unsigned G = gridDim.x * gridDim.y * gridDim.z;
    unsigned sum, cnt, mine, sp = 0u;
    for (;;) {
        sum = 0u; cnt = 0u; mine = 0u;
#pragma unroll
        for (unsigned j = 0; j < 16; ++j) { const unsigned c = xb_ld(&bar[XB_XCNT(j)]); sum += c; cnt += (c > 0u) ? 1u : 0u; mine = (j == x) ? c : mine; }
        if (sum == G) break;
        __builtin_amdgcn_s_sleep(1);
        if ((++sp & 255u) == 0u) { if (xb_ld(&bar[XB_TMO])) break; if (sp > XB_SPIN_CAP) { atomicAdd(&bar[XB_TMO], 1u); break; } }
    }
    nloc = mine > 0u ? mine : 1u; nx = cnt > 0u ? cnt : 1u;
}
__device__ __forceinline__ void xcd_barrier(const XcdBarrier& b, int wave) {
    asm volatile("s_waitcnt vmcnt(0)" ::: "memory");
    __syncthreads();
    if (wave == 0 && lane_id_asm() == 0) {
        unsigned* bar = b.bar;
        __builtin_amdgcn_s_waitcnt(0);
        unsigned nloc = b.st[0], nx = b.st[1];
        if (nloc == 0u) { xcd_barrier_complete(bar, b.x, nloc, nx); b.st[0] = nloc; b.st[1] = nx; }
        const unsigned old = xb_add(&bar[XB_XSUB(b.x)], 1u);
        const unsigned gen = old / nloc;
        if (old + 1u == (gen + 1u) * nloc) {
            __builtin_amdgcn_fence(__ATOMIC_RELEASE, "agent");
            asm volatile("s_waitcnt vmcnt(0)" ::: "memory");
            const unsigned og = xb_add(&bar[XB_TOP], 1u);
            const unsigned tg = og / nx;
            if (og + 1u == (tg + 1u) * nx) xb_add(&bar[XB_TOPGEN], 1u);
            else XB_SPIN(xb_ld(&bar[XB_TOPGEN]) == tg, bar);
            __builtin_amdgcn_fence(__ATOMIC_ACQUIRE, "agent");
            xb_add(&bar[XB_XGEN(b.x)], 1u);
            asm volatile("s_waitcnt vmcnt(0)" ::: "memory");
        } else {
            XB_SPIN(xb_ld(&bar[XB_XGEN(b.x)]) == gen, bar);
            __builtin_amdgcn_fence(__ATOMIC_ACQUIRE, "agent");
            asm volatile("s_waitcnt vmcnt(0)" ::: "memory");
        }
    }
    __syncthreads();
}
}
namespace fk {
__device__ __forceinline__ void tr_item(const float* __restrict__ W, int ldw, int K, int N, bf16* WT, const float* __restrict__ gain, float alpha, LAS float* scr, int item, int lane) {
    const int nblk = N / 32, kb = item / nblk, nb = item % nblk, k0 = 64 * kb, n0 = 32 * nb;
#pragma unroll 8
    for (int i = 0; i < 32; ++i) { const int kk = 2 * i + (lane >> 5); const float g = gain ? gain[k0 + kk] * alpha : alpha;
        scr[kk * 33 + (lane & 31)] = W[(size_t)(k0 + kk) * ldw + n0 + (lane & 31)] * g; }
    LDS_WAIT(); asm volatile("" ::: "memory");
    const int c = lane & 7;
#pragma unroll
    for (int j = 0; j < 4; ++j) { const int n = (lane >> 3) + 8 * j; const LAS float* s = scr + (8 * c) * 33 + n;
        v4u o; o.x = pk2(s[0 * 33], s[1 * 33]); o.y = pk2(s[2 * 33], s[3 * 33]); o.z = pk2(s[4 * 33], s[5 * 33]); o.w = pk2(s[6 * 33], s[7 * 33]);
        *(GAS v4u*)(WT + (size_t)(n0 + n) * K + k0 + 8 * c) = o; }
    LDS_WAIT(); asm volatile("" ::: "memory");
}
__device__ __forceinline__ float row_to_bf16(const float* xrow, bf16* orow, int lane) {
    const GAS f32x4* xr = (const GAS f32x4*)xrow + lane;
    f32x4 v[4]; float s = 0.f;
#pragma unroll
    for (int j = 0; j < 4; ++j) { v[j] = xr[64 * j]; s += (v[j].x * v[j].x + v[j].y * v[j].y) + (v[j].z * v[j].z + v[j].w * v[j].w); }
    s = wave_sum(s);
    GAS unsigned long long* o8 = (GAS unsigned long long*)orow + lane;
#pragma unroll
    for (int j = 0; j < 4; ++j) o8[64 * j] = (unsigned long long)pk2(v[j].x, v[j].y) | ((unsigned long long)pk2(v[j].z, v[j].w) << 32);
    return s;
}
struct PrepJob { const float* W; int ldw, K, N; bf16* WT; const float* gain; float alpha; int items; };
__device__ __forceinline__ void p0_prologue(const float* const* in, unsigned char* ws, LAS unsigned char* lds, int gw, int NGW, int wave) {
    const int lane = lane_id_asm();
    LAS float* scr = (LAS float*)(lds + wave * 16384);
    for (int l = 0; l < 2; ++l) {
        const float* g_mix = in[9] + l * 1024; const float* g_mem = in[24] + l * 1024; const float* g_xa = in[27] + l * 1024; const float* g_ffn = in[30] + l * 1024;
        PrepJob jobs[8];
        jobs[0] = PrepJob{in[10] + (size_t)l * 1024 * NIN, NIN, 1024, 2048, (bf16*)(ws + WS_WIN) + (size_t)l * 2048 * 1024, g_mix, 1.f, 0};
        jobs[1] = PrepJob{in[23] + (size_t)l * 1048576, 1024, 1024, 1024, (bf16*)(ws + WS_WOUT) + (size_t)l * 1048576, nullptr, 1.f, 0};
        jobs[2] = PrepJob{in[28] + (size_t)l * 1048576, 1024, 1024, 1024, (bf16*)(ws + WS_WCQ) + (size_t)l * 1048576, g_xa, 0.0625f, 0};
        jobs[3] = PrepJob{in[29] + (size_t)l * 1048576, 1024, 1024, 1024, (bf16*)(ws + WS_WCO) + (size_t)l * 1048576, nullptr, 1.f, 0};
        jobs[4] = PrepJob{in[31] + (size_t)l * 4194304, 4096, 1024, 4096, (bf16*)(ws + WS_WUP) + (size_t)l * 4194304, g_ffn, 1.f, 0};
        jobs[5] = PrepJob{in[32] + (size_t)l * 4194304, 1024, 4096, 1024, (bf16*)(ws + WS_WDOWN) + (size_t)l * 4194304, nullptr, 1.f, 0};
        jobs[6] = PrepJob{in[25] + (size_t)l * 1048576, 1024, 1024, 1024, (bf16*)(ws + WS_WMEM) + (size_t)l * 2097152, g_mem, 1.f, 0};
        jobs[7] = PrepJob{in[26] + (size_t)l * 1048576, 1024, 1024, 1024, (bf16*)(ws + WS_WMEM) + (size_t)l * 2097152 + 1048576, g_mem, 1.f, 0};
#pragma unroll
        for (int j = 0; j < 8; ++j) {
            const int items = (jobs[j].K / 64) * (jobs[j].N / 32);
            for (int it = gw; it < items; it += NGW) tr_item(jobs[j].W, jobs[j].ldw, jobs[j].K, jobs[j].N, jobs[j].WT, jobs[j].gain, jobs[j].alpha, scr, it, lane);
        }
        for (int it = gw; it < 96; it += NGW) { const int mat = it >> 3, sub = it & 7, which = mat >> 2, h = mat & 3;
            const float* W = in[16 + which] + (size_t)l * 65536 + (size_t)h * 16384;
            bf16* WT = (bf16*)(ws + WS_HW) + ((size_t)(l * 3 + which) * 4 + h) * 16384;
            tr_item(W, 128, 128, 128, WT, nullptr, which == 1 ? 0.08838834764831845f : 1.f, scr, sub, lane); }
        for (int i = gw * 64 + lane; i < 8192; i += NGW * 64) { const int c = i >> 10, k = i & 1023;
            ((float*)(ws + WS_WG))[l * 8192 + i] = in[10][(size_t)l * 1024 * NIN + (size_t)k * NIN + 2048 + c] * g_mix[k]; }
    }
    bf16* XB = (bf16*)(ws + WS_XB); float* SSQ = (float*)(ws + WS_SSQ);
    for (int r = gw; r < MT; r += NGW) {
        const float* src = r < M ? in[0] + (size_t)r * D : in[1] + (size_t)(r - M) * D;
        const float s = row_to_bf16(src, XB + (size_t)r * D, lane);
        if (lane < 16) SSQ[(size_t)r * 16 + lane] = lane == 0 ? s : 0.f;
    }
    for (int r = gw; r < 2048; r += NGW) {
        const float s = row_to_bf16(in[2] + (size_t)r * D, (bf16*)(ws + WS_MB) + (size_t)r * D, lane);
        if (lane == 0) ((float*)(ws + WS_SSQM))[r] = s;
    }
}
}
namespace fk {
using pg8::Unit;
__device__ __forceinline__ float rstd16(const float* SSQ, int row) {
    const f32x4* p = (const f32x4*)(SSQ + (size_t)row * 16); const f32x4 a = p[0], b = p[1], c = p[2], d = p[3];
    const float s = ((a.x + a.y) + (a.z + a.w)) + ((b.x + b.y) + (b.z + b.w)) + ((c.x + c.y) + (c.z + c.w)) + ((d.x + d.y) + (d.z + d.w));
    return rsqrtf(s * (1.f / 1024.f) + EPS);
}
__device__ __forceinline__ v4u pack8(const f32x4 a, const f32x4 b) { v4u w; w.x = cvtpk(a[0], a[1]); w.y = cvtpk(a[2], a[3]); w.z = cvtpk(b[0], b[1]); w.w = cvtpk(b[2], b[3]); return w; }

struct EpiMemKV {
    static constexpr bool PERM = false, AFTER_DRAIN = false;
    float* out; bf16* KB; bf16* VTB; const float* SSQM;
    __device__ __forceinline__ void operator()(const f32x4 (&acc)[2][2][4][2], const Unit& u, int wr, int wc, int fr, int fq) const {
        const int l = u.pn >> 3, isv = (u.pn >> 2) & 1, colt = (u.pn & 3) * 256 + wc * 32 + 4 * fq;
        float* o32 = out + (isv ? O_MV : O_MK) + (size_t)l * 2097152;
#pragma unroll
        for (int ai = 0; ai < 2; ++ai)
#pragma unroll
            for (int m = 0; m < 4; ++m) { const int row = u.pm * 256 + ai * 128 + wr * 64 + m * 16 + fr;
                const float rs = rsqrtf(SSQM[row] * (1.f / 1024.f) + EPS);
#pragma unroll
                for (int bj = 0; bj < 2; ++bj)
#pragma unroll
                    for (int n = 0; n < 2; ++n) { const int col = colt + bj * 128 + n * 16; const f32x4 v = acc[ai][bj][m][n] * rs;
                        *(f32x4*)(o32 + (size_t)row * 1024 + col) = v;
                        if (!isv) { v2u w; w.x = cvtpk(v[0], v[1]); w.y = cvtpk(v[2], v[3]); *(v2u*)(KB + (size_t)l * 2097152 + (size_t)row * 1024 + col) = w; }
                        else { const int b = row >> 8, mm = row & 255;
#pragma unroll
                            for (int e = 0; e < 4; ++e) { const int c = col + e, h = c >> 8, d = c & 255;
                                VTB[(((size_t)(l * 32 + b * 4 + h)) * 256 + d) * 256 + mm] = (bf16)f2bf(v[e]); } } } }
    }
};
struct EpiG1 {
    static constexpr bool PERM = true, AFTER_DRAIN = false;
    bf16 *U, *VG, *XM, *OP; const float* SSQ; float* SSQV; float* convout;
    __device__ __forceinline__ void operator()(const f32x4 (&acc)[2][2][4][2], const Unit& u, int wr, int wc, int fr, int fq) const {
        const int t = u.pn >> 1; bf16* base = t == 0 ? U : (t == 1 ? VG : (t == 2 ? XM : OP));
        const int colb = (u.pn & 1) * 256 + wc * 32 + 8 * fq;
#pragma unroll
        for (int ai = 0; ai < 2; ++ai)
#pragma unroll
            for (int m = 0; m < 4; ++m) { const int row = u.pm * 256 + ai * 128 + wr * 64 + m * 16 + fr;
                const float rs = rstd16(SSQ, row); float ss = 0.f;
#pragma unroll
                for (int bj = 0; bj < 2; ++bj) { f32x4 v0 = acc[ai][bj][m][0] * rs, v1 = acc[ai][bj][m][1] * rs;
                    if (t < 2) {
#pragma unroll
                        for (int e = 0; e < 4; ++e) { v0[e] = gelu_f(v0[e]); v1[e] = gelu_f(v1[e]); }
                        if (t == 1) ss += ((v0[0] * v0[0] + v0[1] * v0[1]) + (v0[2] * v0[2] + v0[3] * v0[3])) + ((v1[0] * v1[0] + v1[1] * v1[1]) + (v1[2] * v1[2] + v1[3] * v1[3])); }
                    *(v4u*)(base + (size_t)row * 512 + colb + bj * 128) = pack8(v0, v1);
                    if (t == 2 && (row & 2047) >= 2045) { float* cp = convout + (size_t)(row >> 11) * 1536 + (size_t)((row & 2047) - 2045) * 512 + colb + bj * 128;
                        *(f32x4*)cp = v0; *(f32x4*)(cp + 4) = v1; } }
                if (t == 1) { ss += __shfl_xor(ss, 16); ss += __shfl_xor(ss, 32); if (fq == 0) SSQV[(size_t)row * 8 + (u.pn & 1) * 4 + wc] = ss; } }
    }
};
struct EpiResid {
    static constexpr bool PERM = false, AFTER_DRAIN = false;
    const float* base; float* X; bf16* XB; float* SSQ;
    __device__ __forceinline__ void operator()(const f32x4 (&acc)[2][2][4][2], const Unit& u, int wr, int wc, int fr, int fq) const {
        const int colt = u.pn * 256 + wc * 32 + 4 * fq;
#pragma unroll
        for (int ai = 0; ai < 2; ++ai)
#pragma unroll
            for (int m = 0; m < 4; ++m) { const size_t row = (size_t)(u.pm * 256 + ai * 128 + wr * 64 + m * 16 + fr); float ss = 0.f;
#pragma unroll
                for (int bj = 0; bj < 2; ++bj)
#pragma unroll
                    for (int n = 0; n < 2; ++n) { const int col = colt + bj * 128 + n * 16; const f32x4 v = *(const f32x4*)(base + row * 1024 + col) + acc[ai][bj][m][n];
                        *(f32x4*)(X + row * 1024 + col) = v; v2u w; w.x = cvtpk(v[0], v[1]); w.y = cvtpk(v[2], v[3]); *(v2u*)(XB + row * 1024 + col) = w;
                        ss += (v[0] * v[0] + v[1] * v[1]) + (v[2] * v[2] + v[3] * v[3]); }
                ss += __shfl_xor(ss, 16); ss += __shfl_xor(ss, 32); if (fq == 0) SSQ[row * 16 + u.pn * 4 + wc] = ss; }
    }
};
template <int ACT> struct EpiScaleBf16 {
    static constexpr bool PERM = true, AFTER_DRAIN = false;
    bf16* O; int ldo; const float* SSQ;
    __device__ __forceinline__ void operator()(const f32x4 (&acc)[2][2][4][2], const Unit& u, int wr, int wc, int fr, int fq) const {
        const int colb = u.pn * 256 + wc * 32 + 8 * fq;
#pragma unroll
        for (int ai = 0; ai < 2; ++ai)
#pragma unroll
            for (int m = 0; m < 4; ++m) { const int row = u.pm * 256 + ai * 128 + wr * 64 + m * 16 + fr; const float rs = rstd16(SSQ, row);
#pragma unroll
                for (int bj = 0; bj < 2; ++bj) { f32x4 v0 = acc[ai][bj][m][0] * rs, v1 = acc[ai][bj][m][1] * rs;
                    if (ACT == 1) {
#pragma unroll
                        for (int e = 0; e < 4; ++e) { const float a = fmaxf(v0[e], 0.f), b = fmaxf(v1[e], 0.f); v0[e] = a * a; v1[e] = b * b; } }
                    *(v4u*)(O + (size_t)row * ldo + colb + bj * 128) = pack8(v0, v1); } }
    }
};
}
namespace fk {
typedef float f32x4m __attribute__((ext_vector_type(4)));
#define MFMA16(a, b, c) __builtin_amdgcn_mfma_f32_16x16x32_bf16((a), (b), (c), 0, 0, 0)
constexpr int IMG_LD = 136;
constexpr int IMG128 = 128 * IMG_LD * 2;
constexpr int IMG144 = 144 * IMG_LD * 2;
__device__ __forceinline__ bf16x8 lds_frag(LAS unsigned char* lds, int img, int row, int k) { return *(const LAS bf16x8*)(lds + img + row * (IMG_LD * 2) + k * 2); }
__device__ __forceinline__ v2u pack4(float a, float b, float c, float d) { v2u w; w.x = cvtpk(a, b); w.y = cvtpk(c, d); return w; }
__device__ __forceinline__ float sigmoid_f(float x) { return __builtin_amdgcn_rcpf(1.f + __expf(-x)); }
__device__ __forceinline__ int opaque(int x) { asm volatile("" : "+v"(x)); return x; }

__device__ __forceinline__ void gate_prelude(unsigned char* ws, int l, int gw_, int NGW) {
    const int lane = lane_id_asm(); int gw = gw_; asm volatile("" : "+s"(gw));
    const float* WG = (const float*)(ws + WS_WG) + l * 8192; const bf16* XB = (const bf16*)(ws + WS_XB); const float* SSQ = (const float*)(ws + WS_SSQ); float* GATES = (float*)(ws + WS_GATES);
    f32x4 w[8][4];
#pragma unroll
    for (int c = 0; c < 8; ++c)
#pragma unroll
        for (int q = 0; q < 2; ++q) { w[c][2 * q] = *(const f32x4*)(WG + c * 1024 + q * 512 + 8 * lane); w[c][2 * q + 1] = *(const f32x4*)(WG + c * 1024 + q * 512 + 8 * lane + 4); }
    for (int r = gw; r < MT; r += NGW) {
        const v4u x0 = *(const v4u*)(XB + (size_t)r * D + 8 * lane), x1 = *(const v4u*)(XB + (size_t)r * D + 512 + 8 * lane);
        float xf[16];
#pragma unroll
        for (int e = 0; e < 4; ++e) { xf[2 * e] = __builtin_bit_cast(float, x0[e] << 16); xf[2 * e + 1] = __builtin_bit_cast(float, x0[e] & 0xffff0000u);
                                       xf[8 + 2 * e] = __builtin_bit_cast(float, x1[e] << 16); xf[8 + 2 * e + 1] = __builtin_bit_cast(float, x1[e] & 0xffff0000u); }
        const float rs = rstd16(SSQ, r);
        float keep = 0.f;
#pragma unroll
        for (int c = 0; c < 8; ++c) { float s = 0.f;
#pragma unroll
            for (int q = 0; q < 4; ++q) s += (xf[4 * q] * w[c][q][0] + xf[4 * q + 1] * w[c][q][1]) + (xf[4 * q + 2] * w[c][q][2] + xf[4 * q + 3] * w[c][q][3]);
            s = wave_sum(s); if (lane == c) keep = s * rs; }
        if (lane < 8) GATES[(size_t)r * 8 + lane] = keep;
    }
}

__device__ __forceinline__ void mlstm_local_unit(const float* const* in, unsigned char* ws, LAS unsigned char* lds, int l, int b, int h, int jj, int wave) {
    const int lane = lane_id_asm(), tid = wave * 64 + lane;
    constexpr int O_WK = 0, O_WV = IMG128, O_KT = 2 * IMG128, O_VT = 3 * IMG128, O_SC = 3 * IMG128 + IMG144;
    LAS float* sS = (LAS float*)(lds + O_SC); LAS float* sG = sS + 128; LAS float* sR = sG + 128;
    const int r0 = b * SEQ + 128 * jj, unit = (b * 4 + h) * 16 + jj;
    const float* GATES = (const float*)(ws + WS_GATES); float* BT = (float*)(ws + WS_BT); float* UNITS = (float*)(ws + WS_UNITS);
    const bf16* XM = (const bf16*)(ws + WS_XM); bf16* CONV = (bf16*)(ws + WS_CONV); bf16* Q = (bf16*)(ws + WS_Q); bf16* KP = (bf16*)(ws + WS_KP); bf16* VT = (bf16*)(ws + WS_VT);
    const bf16* HW = (const bf16*)(ws + WS_HW) + (size_t)l * 3 * 4 * 16384;
    const bf16* wqT = HW + (size_t)(0 * 4 + h) * 16384; const bf16* wkT = HW + (size_t)(1 * 4 + h) * 16384; const bf16* wvT = HW + (size_t)(2 * 4 + h) * 16384;
    __syncthreads();
    float ig = 0.f, bt = 0.f;
    if (tid < 128) { ig = GATES[(size_t)(r0 + tid) * 8 + h] + in[19][l * 4 + h]; const float z = GATES[(size_t)(r0 + tid) * 8 + 4 + h] + in[20][l * 4 + h];
        bt = fminf(z, 0.f) - __logf(1.f + __expf(-fabsf(z))); sS[tid] = bt; }
    __syncthreads();
#pragma unroll
    for (int o = 1; o < 128; o <<= 1) { float add = 0.f; if (tid < 128 && tid >= o) add = sS[tid - o]; __syncthreads(); if (tid < 128) { bt += add; sS[tid] = bt; } __syncthreads(); }
    float gt = ig - bt;
    if (tid < 128) { float mx = gt;
#pragma unroll
        for (int o = 32; o > 0; o >>= 1) mx = fmaxf(mx, __shfl_xor(mx, o));
        if (lane == 0) sR[wave] = mx; }
    __syncthreads();
    const float cmax = fmaxf(sR[0], sR[1]);
    if (tid < 128) { sG[tid] = __expf(gt - cmax); BT[(size_t)(r0 + tid) * 4 + h] = bt; if (tid == 127) { UNITS[unit * 4 + 0] = cmax; UNITS[unit * 4 + 1] = bt; } }
#pragma unroll
    for (int it = 0; it < 8; ++it) { const int ch = tid + it * NTHR, which = ch >> 11, rem = ch & 2047, row = rem >> 4, c16 = rem & 15;
        const v4u v = *(const v4u*)((which ? wvT : wkT) + row * 128 + c16 * 8);
        *(LAS v4u*)(lds + (which ? O_WV : O_WK) + row * (IMG_LD * 2) + c16 * 16) = v; }
    for (int i = tid; i < 16 * IMG_LD / 2; i += NTHR) { const int row = i / (IMG_LD / 2); ((LAS unsigned*)(lds + O_VT + 128 * IMG_LD * 2))[i] = row == 0 ? 0x3f803f80u : 0u; }
    const int fr = lane & 15, g = lane >> 4, t = 16 * wave + fr, pos = 128 * jj + t;
    bf16x8 CA[4], XF[4];
    {
        const float* cw = in[14] + (size_t)l * 2048 + h * 128; const float* cb = in[15] + (size_t)l * 512 + h * 128;
#pragma unroll
        for (int st = 0; st < 4; ++st) { const int c0 = 32 * st + 8 * g;
            float a[8];
            { const f32x4 b0 = *(const f32x4*)(cb + c0), b1 = *(const f32x4*)(cb + c0 + 4);
#pragma unroll
              for (int e = 0; e < 4; ++e) { a[e] = b0[e]; a[4 + e] = b1[e]; } }
#pragma unroll
            for (int i = 0; i < 4; ++i) { v4u xv = (v4u){0u, 0u, 0u, 0u};
                if (pos - 3 + i >= 0) xv = *(const v4u*)(XM + (size_t)(r0 + t - 3 + i) * 512 + h * 128 + c0);
                const f32x4 w0 = *(const f32x4*)(cw + i * 512 + c0), w1 = *(const f32x4*)(cw + i * 512 + c0 + 4);
#pragma unroll
                for (int e = 0; e < 4; ++e) { const float lo = __builtin_bit_cast(float, xv[e] << 16), hi = __builtin_bit_cast(float, xv[e] & 0xffff0000u);
                    a[2 * e] += lo * (e < 2 ? w0[2 * e] : w1[2 * e - 4]); a[2 * e + 1] += hi * (e < 2 ? w0[2 * e + 1] : w1[2 * e - 3]); }
                if (i == 3) XF[st] = __builtin_bit_cast(bf16x8, xv); }
#pragma unroll
            for (int e = 0; e < 8; ++e) a[e] = a[e] * sigmoid_f(a[e]);
            const v4u cv = (v4u){cvtpk(a[0], a[1]), cvtpk(a[2], a[3]), cvtpk(a[4], a[5]), cvtpk(a[6], a[7])};
            CA[st] = __builtin_bit_cast(bf16x8, cv);
            *(v4u*)(CONV + (size_t)(r0 + t) * 512 + h * 128 + c0) = cv; }
    }
    __syncthreads();
    const float sgY = sG[t];
    f32x4 sgX; sgX[0] = sG[16 * wave + 4 * g]; sgX[1] = sG[16 * wave + 4 * g + 1]; sgX[2] = sG[16 * wave + 4 * g + 2]; sgX[3] = sG[16 * wave + 4 * g + 3];
#pragma unroll 1
    for (int it = 0; it < 8; ++it) {
        f32x4 aq = (f32x4){0.f, 0.f, 0.f, 0.f}, ak = aq, akx = aq, avx = aq;
#pragma unroll
        for (int st = 0; st < 4; ++st) {
            const bf16x8 wq = *(const bf16x8*)(wqT + (16 * it + fr) * 128 + 32 * st + 8 * g);
            const bf16x8 wk = lds_frag(lds, O_WK, 16 * it + fr, 32 * st + 8 * g), wv = lds_frag(lds, O_WV, 16 * it + fr, 32 * st + 8 * g);
            aq = MFMA16(wq, CA[st], aq); ak = MFMA16(wk, CA[st], ak); akx = MFMA16(CA[st], wk, akx); avx = MFMA16(XF[st], wv, avx);
        }
        *(v2u*)(Q + (size_t)(r0 + t) * 512 + h * 128 + 16 * it + 4 * g) = pack4(aq[0], aq[1], aq[2], aq[3]);
        *(v2u*)(KP + (size_t)(r0 + t) * 512 + h * 128 + 16 * it + 4 * g) = pack4(ak[0] * sgY, ak[1] * sgY, ak[2] * sgY, ak[3] * sgY);
        *(LAS v2u*)(lds + O_KT + (16 * it + fr) * (IMG_LD * 2) + (16 * wave + 4 * g) * 2) = pack4(akx[0] * sgX[0], akx[1] * sgX[1], akx[2] * sgX[2], akx[3] * sgX[3]);
        const v2u vv = pack4(avx[0], avx[1], avx[2], avx[3]);
        *(LAS v2u*)(lds + O_VT + (16 * it + fr) * (IMG_LD * 2) + (16 * wave + 4 * g) * 2) = vv;
        *(v2u*)(VT + ((size_t)(b * 4 + h) * 128 + 16 * it + fr) * SEQ + 128 * jj + 16 * wave + 4 * g) = vv;
        __builtin_amdgcn_sched_barrier(0);
    }
    __syncthreads();
    float* UE = (float*)(ws + WS_UEXT) + (size_t)unit * 144 * 128;
    bf16x8 kf[4];
#pragma unroll
    for (int st = 0; st < 4; ++st) kf[st] = lds_frag(lds, O_KT, 16 * wave + fr, 32 * st + 8 * g);
#pragma unroll 1
    for (int dt = 0; dt < 9; ++dt) { f32x4 au = (f32x4){0.f, 0.f, 0.f, 0.f};
#pragma unroll
        for (int st = 0; st < 4; ++st) au = MFMA16(kf[st], lds_frag(lds, O_VT, 16 * dt + fr, 32 * st + 8 * g), au);
        *(f32x4*)(UE + (size_t)(16 * dt + fr) * 128 + 16 * wave + 4 * g) = au; __builtin_amdgcn_sched_barrier(0); }
}

__device__ __forceinline__ void gmlp_unit(const float* const* in, unsigned char* ws, LAS unsigned char* lds, int l, int b, int n, int h, int wave) {
    const int lane = lane_id_asm(), tid = wave * 64 + lane;
    constexpr int O_WS = 0, O_VG = IMG128, O_RS = 2 * IMG128;
    LAS float* sRS = (LAS float*)(lds + O_RS);
    const int r0 = b * SEQ + 128 * n;
    const bf16* VG = (const bf16*)(ws + WS_VG); const bf16* U = (const bf16*)(ws + WS_U); bf16* YMIX = (bf16*)(ws + WS_YMIX); const float* SSQV = (const float*)(ws + WS_SSQV);
    const float* wsp = in[12] + (size_t)l * 65536 + (size_t)h * 16384; const float* bsp = in[13] + (size_t)l * 512 + h * 128; const float* gvg = in[11] + (size_t)l * 512 + h * 128;
    __syncthreads();
    if (tid < 128) { const f32x4 a = *(const f32x4*)(SSQV + (size_t)(r0 + tid) * 8), c = *(const f32x4*)(SSQV + (size_t)(r0 + tid) * 8 + 4);
        sRS[tid] = rsqrtf((((a[0] + a[1]) + (a[2] + a[3])) + ((c[0] + c[1]) + (c[2] + c[3]))) * (1.f / 512.f) + EPS); }
    __syncthreads();
#pragma unroll
    for (int it = 0; it < 8; ++it) { const int ch = tid + it * NTHR, tt = ch >> 5, s0 = (ch & 31) * 4; const f32x4 w = *(const f32x4*)(wsp + tt * 128 + s0);
        float v[4];
#pragma unroll
        for (int e = 0; e < 4; ++e) v[e] = (s0 + e <= tt) ? w[e] * sRS[s0 + e] : 0.f;
        *(LAS v2u*)(lds + O_WS + tt * (IMG_LD * 2) + s0 * 2) = pack4(v[0], v[1], v[2], v[3]); }
#pragma unroll
    for (int it = 0; it < 4; ++it) { const int ch = tid + it * NTHR, s = ch & 127, d0 = (ch >> 7) * 8; const v4u v = *(const v4u*)(VG + (size_t)(r0 + s) * 512 + h * 128 + d0);
#pragma unroll
        for (int e = 0; e < 4; ++e) { *(LAS unsigned short*)(lds + O_VG + (d0 + 2 * e) * (IMG_LD * 2) + s * 2) = (unsigned short)(v[e] & 0xffffu);
                                       *(LAS unsigned short*)(lds + O_VG + (d0 + 2 * e + 1) * (IMG_LD * 2) + s * 2) = (unsigned short)(v[e] >> 16); } }
    __syncthreads();
    const int fr = lane & 15, g = lane >> 4, t = 16 * wave + fr, nst = (16 * wave + 15) / 32 + 1;
    bf16x8 wf[4];
#pragma unroll
    for (int st = 0; st < 4; ++st) wf[st] = lds_frag(lds, O_WS, t, 32 * st + 8 * g);
    const float bsv = bsp[t];
#pragma unroll 1
    for (int dt = 0; dt < 8; ++dt) { f32x4 am = (f32x4){0.f, 0.f, 0.f, 0.f};
#pragma unroll
        for (int st = 0; st < 4; ++st) if (st < nst) am = MFMA16(lds_frag(lds, O_VG, 16 * dt + fr, 32 * st + 8 * g), wf[st], am);
        const int d0 = 16 * dt + 4 * g; const f32x4 gv = *(const f32x4*)(gvg + d0);
        const v2u uu = *(const v2u*)(U + (size_t)(r0 + t) * 512 + h * 128 + d0);
        const float u0 = __builtin_bit_cast(float, uu[0] << 16), u1 = __builtin_bit_cast(float, uu[0] & 0xffff0000u), u2 = __builtin_bit_cast(float, uu[1] << 16), u3 = __builtin_bit_cast(float, uu[1] & 0xffff0000u);
        *(v2u*)(YMIX + (size_t)(r0 + t) * 1024 + h * 128 + d0) = pack4(u0 * (am[0] * gv[0] + bsv), u1 * (am[1] * gv[1] + bsv), u2 * (am[2] * gv[2] + bsv), u3 * (am[3] * gv[3] + bsv)); }
}

__device__ __forceinline__ void mlstm_out_unit(const float* const* in, unsigned char* ws, float* out, LAS unsigned char* lds, int l, int b, int h, int jj, int wave) {
    const int lane = lane_id_asm(), tid = wave * 64 + lane;
    constexpr int O_K = 0, O_V = IMG128, O_C = IMG128 + IMG144, O_P = IMG128 + 2 * IMG144, PW = 16 * IMG_LD * 2;
    const int r0 = b * SEQ + 128 * jj, ubase = (b * 4 + h) * 16;
    const float* UNITS = (const float*)(ws + WS_UNITS); const float* BT = (const float*)(ws + WS_BT);
    const bf16* Q = (const bf16*)(ws + WS_Q); const bf16* KP = (const bf16*)(ws + WS_KP); const bf16* VT = (const bf16*)(ws + WS_VT); const bf16* CONV = (const bf16*)(ws + WS_CONV); const bf16* OP = (const bf16*)(ws + WS_OP);
    bf16* YMIX = (bf16*)(ws + WS_YMIX); const float* UEX = (const float*)(ws + WS_UEXT) + (size_t)ubase * 144 * 128;
    __syncthreads();
    const float cj = UNITS[(ubase + jj) * 4 + 0];
    {
        f32x4 accv[9];
#pragma unroll
        for (int q = 0; q < 9; ++q) accv[q] = (f32x4){0.f, 0.f, 0.f, 0.f};
        float suffix = 0.f;
        for (int x = jj - 1; x >= 0; --x) { const float cx = UNITS[(ubase + x) * 4 + 0], blx = UNITS[(ubase + x) * 4 + 1]; const float w = __expf(blx + cx + suffix - cj); suffix += blx;
            const float* up = UEX + (size_t)x * 144 * 128;
#pragma unroll
            for (int q = 0; q < 9; ++q) accv[q] += *(const f32x4*)(up + (size_t)(tid + q * NTHR) * 4) * w; }
#pragma unroll
        for (int q = 0; q < 9; ++q) { const int e = (tid + q * NTHR) * 4, d = e >> 7, i = e & 127;
            *(LAS v2u*)(lds + O_C + d * (IMG_LD * 2) + i * 2) = pack4(accv[q][0], accv[q][1], accv[q][2], accv[q][3]); }
    }
#pragma unroll
    for (int it = 0; it < 4; ++it) { const int ch = tid + it * NTHR, row = ch >> 4, c16 = ch & 15;
        *(LAS v4u*)(lds + O_K + row * (IMG_LD * 2) + c16 * 16) = *(const v4u*)(KP + (size_t)(r0 + row) * 512 + h * 128 + c16 * 8);
        *(LAS v4u*)(lds + O_V + row * (IMG_LD * 2) + c16 * 16) = *(const v4u*)(VT + ((size_t)(b * 4 + h) * 128 + row) * SEQ + 128 * jj + c16 * 8); }
    for (int i = tid; i < 16 * IMG_LD / 2; i += NTHR) { const int row = i / (IMG_LD / 2); ((LAS unsigned*)(lds + O_V + 128 * IMG_LD * 2))[i] = row == 0 ? 0x3f803f80u : 0u; }
    const int fr = lane & 15, g = lane >> 4, t = 16 * wave + fr;
    bf16x8 qf[4];
#pragma unroll
    for (int st = 0; st < 4; ++st) qf[st] = *(const bf16x8*)(Q + (size_t)(r0 + t) * 512 + h * 128 + 32 * st + 8 * g);
    __syncthreads();
    const int pw = O_P + wave * PW;
    for (int n = 0; n <= wave; ++n) { f32x4 as = (f32x4){0.f, 0.f, 0.f, 0.f};
#pragma unroll
        for (int st = 0; st < 4; ++st) as = MFMA16(lds_frag(lds, O_K, 16 * n + fr, 32 * st + 8 * g), qf[st], as);
        if (n == wave) {
#pragma unroll
            for (int r = 0; r < 4; ++r) if (4 * g + r > fr) as[r] = 0.f; }
        *(LAS v2u*)(lds + pw + fr * (IMG_LD * 2) + (16 * n + 4 * g) * 2) = pack4(as[0], as[1], as[2], as[3]); }
    if ((wave & 1) == 0) *(LAS v2u*)(lds + pw + fr * (IMG_LD * 2) + (16 * (wave + 1) + 4 * g) * 2) = (v2u){0u, 0u};
    LDS_WAIT(); asm volatile("" ::: "memory");
    const int nst = (wave >> 1) + 1;
    bf16x8 pf[4];
#pragma unroll
    for (int st = 0; st < 4; ++st) pf[st] = (st < nst) ? lds_frag(lds, pw, fr, 32 * st + 8 * g) : qf[0];
    f32x4 hv[9];
#pragma unroll
    for (int dt = 0; dt < 9; ++dt) { f32x4 a2 = (f32x4){0.f, 0.f, 0.f, 0.f};
#pragma unroll
        for (int st = 0; st < 4; ++st) if (st < nst) a2 = MFMA16(lds_frag(lds, O_V, 16 * dt + fr, 32 * st + 8 * g), pf[st], a2);
#pragma unroll
        for (int st = 0; st < 4; ++st) a2 = MFMA16(lds_frag(lds, O_C, 16 * dt + fr, 32 * st + 8 * g), qf[st], a2);
        hv[dt] = a2; __builtin_amdgcn_sched_barrier(0); }
    const float den = __shfl(hv[8][0], fr);
    const float btv = BT[(size_t)(r0 + t) * 4 + h];
    const float inv = __builtin_amdgcn_rcpf(fmaxf(fabsf(den), __expf(-(btv + cj))));
    float ss = 0.f;
#pragma unroll
    for (int dt = 0; dt < 8; ++dt) { hv[dt] = hv[dt] * inv; ss += (hv[dt][0] * hv[dt][0] + hv[dt][1] * hv[dt][1]) + (hv[dt][2] * hv[dt][2] + hv[dt][3] * hv[dt][3]); }
    ss += __shfl_xor(ss, 16); ss += __shfl_xor(ss, 32);
    const float rs = rsqrtf(ss * (1.f / 128.f) + EPS);
    const float* og = in[21] + (size_t)l * 512 + h * 128; const float* sk = in[22] + (size_t)l * 512 + h * 128;
#pragma unroll
    for (int dt = 0; dt < 8; ++dt) { const int d0 = 16 * dt + 4 * g; const f32x4 ogv = *(const f32x4*)(og + d0), skv = *(const f32x4*)(sk + d0);
        const v2u ov = *(const v2u*)(OP + (size_t)(r0 + t) * 512 + h * 128 + d0), cv = *(const v2u*)(CONV + (size_t)(r0 + t) * 512 + h * 128 + d0);
        float o[4], c[4];
        o[0] = __builtin_bit_cast(float, ov[0] << 16); o[1] = __builtin_bit_cast(float, ov[0] & 0xffff0000u); o[2] = __builtin_bit_cast(float, ov[1] << 16); o[3] = __builtin_bit_cast(float, ov[1] & 0xffff0000u);
        c[0] = __builtin_bit_cast(float, cv[0] << 16); c[1] = __builtin_bit_cast(float, cv[0] & 0xffff0000u); c[2] = __builtin_bit_cast(float, cv[1] << 16); c[3] = __builtin_bit_cast(float, cv[1] & 0xffff0000u);
        float y[4];
#pragma unroll
        for (int e = 0; e < 4; ++e) y[e] = sigmoid_f(o[e]) * (hv[dt][e] * rs * ogv[e] + skv[e] * c[e]);
        *(v2u*)(YMIX + (size_t)(r0 + t) * 1024 + 512 + h * 128 + d0) = pack4(y[0], y[1], y[2], y[3]); __builtin_amdgcn_sched_barrier(0); }
    if (jj == 15) {
        float m = 0.f;
        for (int x = 0; x < 16; ++x) { const float cx = UNITS[(ubase + x) * 4 + 0], blx = UNITS[(ubase + x) * 4 + 1]; m = fmaxf(blx + m, blx + cx); }
        f32x4 accv[9];
#pragma unroll
        for (int q = 0; q < 9; ++q) accv[q] = (f32x4){0.f, 0.f, 0.f, 0.f};
        float suffix = 0.f;
        for (int x = 15; x >= 0; --x) { const float cx = UNITS[(ubase + x) * 4 + 0], blx = UNITS[(ubase + x) * 4 + 1]; const float w = __expf(blx + cx + suffix - m); suffix += blx;
            const float* up = UEX + (size_t)x * 144 * 128;
#pragma unroll
            for (int q = 0; q < 9; ++q) accv[q] += *(const f32x4*)(up + (size_t)(tid + q * NTHR) * 4) * w; }
        float* Cp = out + O_CP + (size_t)l * 524288 + (size_t)(b * 4 + h) * 16384; float* Np = out + O_NP + (size_t)l * 4096 + (b * 4 + h) * 128;
#pragma unroll
        for (int q = 0; q < 9; ++q) { const int e = (tid + q * NTHR) * 4, d = e >> 7, i = e & 127;
            if (d < 128) {
#pragma unroll
                for (int k = 0; k < 4; ++k) Cp[(size_t)(i + k) * 128 + d] = accv[q][k]; }
            else if (d == 128) *(f32x4*)(Np + i) = accv[q]; }
        if (tid == 0) out[O_MP + l * 32 + b * 4 + h] = m;
    }
}
}
namespace fk {
constexpr int ATT_LD = 264;
__device__ __forceinline__ void attn_unit(unsigned char* ws, LAS unsigned char* lds, int l, int pm, int h, int wave) {
    const int lane = lane_id_asm(), tid = wave * 64 + lane, fr = lane & 15, g = lane >> 4;
    const int b = pm >> 3;
    const bf16* QA = (const bf16*)(ws + WS_QA); bf16* ATT = (bf16*)(ws + WS_ATT);
    const bf16* KB = (const bf16*)(ws + WS_KB) + (size_t)l * 2097152 + (size_t)b * 256 * 1024 + h * 256;
    const bf16* VTB = (const bf16*)(ws + WS_VTB) + ((size_t)(l * 32 + b * 4 + h)) * 65536;
    __syncthreads();
#pragma unroll
    for (int it = 0; it < 16; ++it) { const int ch = tid + it * NTHR, row = ch >> 5, c16 = ch & 31;
        *(LAS v4u*)(lds + row * (ATT_LD * 2) + c16 * 16) = *(const v4u*)(KB + (size_t)row * 1024 + c16 * 8); }
    __syncthreads();
    bf16x8 pfr[2][8]; float inv[2];
#pragma unroll
    for (int tt = 0; tt < 2; ++tt) {
        const int row = pm * 256 + 32 * wave + 16 * tt + fr;
        bf16x8 qf[8];
#pragma unroll
        for (int st = 0; st < 8; ++st) qf[st] = *(const bf16x8*)(QA + (size_t)row * 1024 + h * 256 + 32 * st + 8 * g);
        f32x4 sacc[16];
#pragma unroll
        for (int mt = 0; mt < 16; ++mt) { f32x4 a = (f32x4){0.f, 0.f, 0.f, 0.f};
#pragma unroll
            for (int st = 0; st < 8; ++st) a = MFMA16(*(const LAS bf16x8*)(lds + (16 * mt + fr) * (ATT_LD * 2) + (32 * st + 8 * g) * 2), qf[st], a);
            sacc[mt] = a; }
        float mx = -3.0e38f;
#pragma unroll
        for (int mt = 0; mt < 16; ++mt) mx = fmaxf(fmaxf(mx, fmaxf(sacc[mt][0], sacc[mt][1])), fmaxf(sacc[mt][2], sacc[mt][3]));
        mx = fmaxf(mx, __shfl_xor(mx, 16)); mx = fmaxf(mx, __shfl_xor(mx, 32));
        float sum = 0.f;
#pragma unroll
        for (int mt = 0; mt < 16; ++mt) {
#pragma unroll
            for (int r = 0; r < 4; ++r) { const float p = __expf(sacc[mt][r] - mx); sacc[mt][r] = p; sum += p; } }
        sum += __shfl_xor(sum, 16); sum += __shfl_xor(sum, 32);
        inv[tt] = __builtin_amdgcn_rcpf(sum);
#pragma unroll
        for (int st = 0; st < 8; ++st) { const v4u w = (v4u){cvtpk(sacc[2 * st][0], sacc[2 * st][1]), cvtpk(sacc[2 * st][2], sacc[2 * st][3]), cvtpk(sacc[2 * st + 1][0], sacc[2 * st + 1][1]), cvtpk(sacc[2 * st + 1][2], sacc[2 * st + 1][3])};
            pfr[tt][st] = __builtin_bit_cast(bf16x8, w); }
        __builtin_amdgcn_sched_barrier(0);
    }
    __syncthreads();
#pragma unroll
    for (int it = 0; it < 16; ++it) { const int ch = tid + it * NTHR, row = ch >> 5, c16 = ch & 31;
        *(LAS v4u*)(lds + row * (ATT_LD * 2) + c16 * 16) = *(const v4u*)(VTB + (size_t)row * 256 + c16 * 8); }
    __syncthreads();
    const int row0 = pm * 256 + 32 * wave + fr;
#pragma unroll 2
    for (int dt = 0; dt < 16; ++dt) { f32x4 a0 = (f32x4){0.f, 0.f, 0.f, 0.f}, a1 = a0;
#pragma unroll
        for (int st = 0; st < 8; ++st) { const LAS unsigned char* p = lds + (16 * dt + fr) * (ATT_LD * 2) + (32 * st + 4 * g) * 2;
            const v2u lo = *(const LAS v2u*)p, hi = *(const LAS v2u*)(p + 32); const v4u w = (v4u){lo[0], lo[1], hi[0], hi[1]}; const bf16x8 vf = __builtin_bit_cast(bf16x8, w);
            a0 = MFMA16(vf, pfr[0][st], a0); a1 = MFMA16(vf, pfr[1][st], a1); }
        *(v2u*)(ATT + (size_t)row0 * 1024 + h * 256 + 16 * dt + 4 * g) = pack4(a0[0] * inv[0], a0[1] * inv[0], a0[2] * inv[0], a0[3] * inv[0]);
        *(v2u*)(ATT + (size_t)(row0 + 16) * 1024 + h * 256 + 16 * dt + 4 * g) = pack4(a1[0] * inv[1], a1[1] * inv[1], a1[2] * inv[1], a1[3] * inv[1]);
        __builtin_amdgcn_sched_barrier(0); }
}
__device__ __forceinline__ void final_norm_rows(const float* X, const float* SSQ, const float* gf, float* yp, float* ys, int gw_, int NGW) {
    const int lane = lane_id_asm(); int gw = gw_; asm volatile("" : "+s"(gw));
    for (int r = gw; r < MT; r += NGW) { const float rs = rstd16(SSQ, r); float* dst = r < M ? yp + (size_t)r * D : ys + (size_t)(r - M) * D;
#pragma unroll
        for (int j = 0; j < 4; ++j) { const f32x4 v = *(const f32x4*)(X + (size_t)r * D + 4 * lane + 256 * j), gv = *(const f32x4*)(gf + 4 * lane + 256 * j); *(f32x4*)(dst + 4 * lane + 256 * j) = v * rs * gv; } }
}
}
namespace fk {
constexpr size_t WS_PROJS = WS_SAMP, WS_YMIXS = WS_SAMP + 1 * MiB, WS_QS = WS_SAMP + 2 * MiB, WS_ATTS = WS_SAMP + 3 * MiB, WS_HMIDS = WS_SAMP + 4 * MiB;
__device__ __forceinline__ float block_sum512(float v, LAS float* red, int wave, int lane) {
    v = wave_sum(v); if (lane == 0) red[wave] = v; __syncthreads();
    float s = ((red[0] + red[1]) + (red[2] + red[3])) + ((red[4] + red[5]) + (red[6] + red[7])); __syncthreads(); return s;
}
template <int MODE>
__device__ __forceinline__ void skinny_unit(unsigned char* ws, LAS unsigned char* lds, const bf16* A, int lda, const bf16* Bt, int K, int rg, int cg, float* outf, int ldo, bf16* outb, int wave, const float* xbase = nullptr) {
    const int lane = lane_id_asm(), tid = wave * 64 + lane, fr = lane & 15, g = lane >> 4;
    const int ks = K >> 3, k0 = wave * ks;
    const bf16* ap = A + (size_t)(16 * rg + fr) * lda + k0 + 8 * g;
    const bf16* bp = Bt + (size_t)(64 * cg + fr) * K + k0 + 8 * g;
    f32x4 acc[4];
#pragma unroll
    for (int nt = 0; nt < 4; ++nt) acc[nt] = (f32x4){0.f, 0.f, 0.f, 0.f};
    for (int kk = 0; kk < ks; kk += 128) {
        bf16x8 af[4], bfr[4][4];
#pragma unroll
        for (int st = 0; st < 4; ++st) { af[st] = *(const bf16x8*)(ap + kk + 32 * st);
#pragma unroll
            for (int nt = 0; nt < 4; ++nt) bfr[nt][st] = *(const bf16x8*)(bp + (size_t)(16 * nt) * K + kk + 32 * st); }
#pragma unroll
        for (int st = 0; st < 4; ++st)
#pragma unroll
            for (int nt = 0; nt < 4; ++nt) acc[nt] = MFMA16(bfr[nt][st], af[st], acc[nt]);
    }
    __syncthreads();
    LAS float* red = (LAS float*)lds;
#pragma unroll
    for (int nt = 0; nt < 4; ++nt) *(LAS f32x4*)(red + wave * 1024 + fr * 64 + 16 * nt + 4 * g) = acc[nt];
    __syncthreads();
    const int row = tid >> 5, c2 = (tid & 31) * 2;
    float v0 = 0.f, v1 = 0.f;
#pragma unroll
    for (int w = 0; w < 8; ++w) { const f32x2 p = *(const LAS f32x2*)(red + w * 1024 + row * 64 + c2); v0 += p[0]; v1 += p[1]; }
    const int grow = M + 16 * rg + row, col = 64 * cg + c2;
    if (MODE == 0) { const float rs = rstd16((const float*)(ws + WS_SSQ), grow); *(f32x2*)(outf + (size_t)(16 * rg + row) * ldo + col) = (f32x2){v0 * rs, v1 * rs}; }
    else if (MODE == 2) { const float rs = rstd16((const float*)(ws + WS_SSQ), grow); const float a = fmaxf(v0 * rs, 0.f), b = fmaxf(v1 * rs, 0.f);
        *(unsigned*)(outb + (size_t)(16 * rg + row) * ldo + col) = cvtpk(a * a, b * b); }
    else { float* X = (float*)(ws + WS_X) + (size_t)grow * D + col; const f32x2 xo = *(const f32x2*)(xbase + (size_t)(16 * rg + row) * D + col); const float x0 = xo[0] + v0, x1 = xo[1] + v1;
        *(f32x2*)X = (f32x2){x0, x1}; *(unsigned*)((bf16*)(ws + WS_XB) + (size_t)grow * D + col) = cvtpk(x0, x1);
        float ss = x0 * x0 + x1 * x1;
#pragma unroll
        for (int o = 1; o < 32; o <<= 1) ss += __shfl_xor(ss, o);
        if ((tid & 31) == 0) ((float*)(ws + WS_SSQ))[(size_t)grow * 16 + cg] = ss; }
}
__device__ __forceinline__ void sample_mix_unit(const float* const* in, unsigned char* ws, float* out, LAS unsigned char* lds, int l, int b, int h, int wave) {
    const int lane = lane_id_asm(), tid = wave * 64 + lane;
    LAS float* red = (LAS float*)lds; LAS float* sconv = red + 16; LAS float* sxm = sconv + 128; LAS float* sq = sxm + 128; LAS float* sk = sq + 128; LAS float* sv = sk + 128; LAS float* snum = sv + 128;
    const float* PROJ = (const float*)(ws + WS_PROJS) + (size_t)b * 2048; bf16* YM = (bf16*)(ws + WS_YMIXS) + (size_t)b * 1024; const float* GATES = (const float*)(ws + WS_GATES) + (size_t)(M + b) * 8;
    __syncthreads();
    const float vraw = gelu_f(PROJ[512 + tid]);
    const float rsv = rsqrtf(block_sum512(vraw * vraw, red, wave, lane) * (1.f / 512.f) + EPS);
    const float vn = vraw * rsv * in[11][l * 512 + tid];
    if (h == 0) out[O_GV + (size_t)l * 65536 + b * 512 + tid] = vn;
    if ((tid >> 7) == h) { const float u = gelu_f(PROJ[tid]); const float y = u * (in[12][(size_t)l * 65536 + (size_t)h * 16384] * vn + in[13][l * 512 + h * 128]); YM[tid] = (bf16)f2bf(y); }
    if (tid < 128) { const int c = h * 128 + tid; const float xm = PROJ[1024 + c]; const float* sc = in[8] + ((size_t)(l * 128 + b) * 3) * 512 + c; const float* cw = in[14] + (size_t)l * 2048 + c;
        const float s0 = sc[0], s1 = sc[512], s2 = sc[1024]; const float a = in[15][l * 512 + c] + cw[0] * s0 + cw[512] * s1 + cw[1024] * s2 + cw[1536] * xm;
        sconv[tid] = a * sigmoid_f(a); sxm[tid] = xm;
        float* co = out + O_CVS + (size_t)l * 196608 + (size_t)b * 1536 + c; co[0] = s1; co[512] = s2; co[1024] = xm; }
    __syncthreads();
    if (tid < 384) { const int which = tid >> 7, e = tid & 127; const float* W = in[16 + which] + (size_t)l * 65536 + (size_t)h * 16384 + e; const LAS float* src = which == 2 ? sxm : sconv;
        float a = 0.f;
#pragma unroll 8
        for (int d = 0; d < 128; ++d) a += src[d] * W[d * 128];
        if (which == 0) sq[e] = a; else if (which == 1) sk[e] = a * 0.08838834764831845f; else sv[e] = a; }
    const float ig = GATES[h] + in[19][l * 4 + h]; const float z = GATES[4 + h] + in[20][l * 4 + h]; const float lf = fminf(z, 0.f) - __logf(1.f + __expf(-fabsf(z)));
    const float m0 = in[7][l * 512 + b * 4 + h]; const float mn = fmaxf(lf + m0, ig), fd = __expf(lf + m0 - mn), iw = __expf(ig - mn);
    __syncthreads();
    {
        const int v = tid & 127, kg = tid >> 7; const size_t so = ((size_t)(l * 128 + b) * 4 + h) * 16384;
        const float* C0 = in[5] + so + (size_t)(kg * 32) * 128 + v; float* Co = out + O_CS + so + (size_t)(kg * 32) * 128 + v;
        const float ivv = iw * sv[v]; float num = 0.f;
#pragma unroll 8
        for (int kk = 0; kk < 32; ++kk) { const float c = fd * C0[kk * 128] + sk[kg * 32 + kk] * ivv; Co[kk * 128] = c; num += sq[kg * 32 + kk] * c; }
        snum[kg * 128 + v] = num;
    }
    float dp = 0.f;
    if (tid < 128) { const size_t no = ((size_t)(l * 128 + b) * 4 + h) * 128 + tid; const float nn = fd * in[6][no] + iw * sk[tid]; out[O_NS + no] = nn; dp = sq[tid] * nn; }
    const float den = block_sum512(dp, red, wave, lane);
    float hv = 0.f;
    if (tid < 128) hv = ((snum[tid] + snum[128 + tid]) + (snum[256 + tid] + snum[384 + tid])) * __builtin_amdgcn_rcpf(fmaxf(fabsf(den), __expf(-mn)));
    const float rs = rsqrtf(block_sum512(hv * hv, red, wave, lane) * (1.f / 128.f) + EPS);
    if (tid < 128) { const int c = h * 128 + tid; const float o = PROJ[1536 + c];
        YM[512 + c] = (bf16)f2bf(sigmoid_f(o) * (hv * rs * in[21][l * 512 + c] + in[22][l * 512 + c] * sconv[tid]));
        if (tid == 0) out[O_MS + l * 512 + b * 4 + h] = mn; }
}
__device__ __forceinline__ void sample_attn_unit(const float* const* in, unsigned char* ws, LAS unsigned char* lds, int l, int b, int h, int wave) {
    const int lane = lane_id_asm(), tid = wave * 64 + lane;
    LAS float* red = (LAS float*)lds; LAS float* sp = red + 16; LAS float* sacc = sp + 256;
    const float* Kc = in[3] + ((size_t)(l * 128 + b) * 256) * 1024 + h * 256 + 4 * lane; const float* Vc = in[4] + ((size_t)(l * 128 + b) * 256) * 1024 + h * 256 + 4 * lane;
    const f32x4 q = *(const f32x4*)((const float*)(ws + WS_QS) + (size_t)b * 1024 + h * 256 + 4 * lane);
    __syncthreads();
    float myscore = 0.f;
#pragma unroll 1
    for (int i0 = 0; i0 < 32; i0 += 8) { f32x4 kv[8];
#pragma unroll
        for (int i = 0; i < 8; ++i) kv[i] = __builtin_nontemporal_load((const f32x4*)(Kc + (size_t)(32 * wave + i0 + i) * 1024));
#pragma unroll
        for (int i = 0; i < 8; ++i) { const float s = wave_sum((kv[i][0] * q[0] + kv[i][1] * q[1]) + (kv[i][2] * q[2] + kv[i][3] * q[3])); if (lane == i0 + i) myscore = s; } }
    if (lane < 32) sp[32 * wave + lane] = myscore;
    __syncthreads();
    float s = tid < 256 ? sp[tid] : -3.0e38f; float mx = s;
#pragma unroll
    for (int o = 1; o < 64; o <<= 1) mx = fmaxf(mx, __shfl_xor(mx, o));
    if (lane == 0) red[wave] = mx; __syncthreads();
    mx = fmaxf(fmaxf(red[0], red[1]), fmaxf(red[2], red[3])); __syncthreads();
    const float p = tid < 256 ? __expf(s - mx) : 0.f;
    const float tot = block_sum512(p, red, wave, lane);
    if (tid < 256) sp[tid] = p * __builtin_amdgcn_rcpf(tot);
    __syncthreads();
    f32x4 acc = (f32x4){0.f, 0.f, 0.f, 0.f};
#pragma unroll 1
    for (int i0 = 0; i0 < 32; i0 += 8) { f32x4 vv[8];
#pragma unroll
        for (int i = 0; i < 8; ++i) vv[i] = __builtin_nontemporal_load((const f32x4*)(Vc + (size_t)(32 * wave + i0 + i) * 1024));
#pragma unroll
        for (int i = 0; i < 8; ++i) acc += vv[i] * sp[32 * wave + i0 + i]; }
    *(LAS f32x4*)(sacc + wave * 256 + 4 * lane) = acc;
    __syncthreads();
    if (tid < 256) { float a = 0.f;
#pragma unroll
        for (int w = 0; w < 8; ++w) a += sacc[w * 256 + tid];
        ((bf16*)(ws + WS_ATTS))[(size_t)b * 1024 + h * 256 + tid] = (bf16)f2bf(a); }
}
}
namespace fk {
constexpr int PH_PREP = 0, PH_MEMKV = 1, PH_L0 = 2, PH_PER_LAYER = 9, PH_FINAL = 20, NPH = 21;
constexpr int LP_G1 = 0, LP_M1 = 1, LP_M2 = 2, LP_G2 = 3, LP_G3 = 4, LP_ATT = 5, LP_G4 = 6, LP_G5 = 7, LP_G6 = 8;
struct Args { const float* in[34]; float* out; unsigned char* ws; int ph_lo, ph_hi, region, pad; };

__global__ void __launch_bounds__(NTHR, 2) fwd(Args a) {
    extern __shared__ __attribute__((aligned(16))) unsigned char lds_raw[];
    LAS unsigned char* lds = (LAS unsigned char*)lds_raw;
    volatile LAS unsigned* MISC = (volatile LAS unsigned*)(lds + MISC_OFF);
    const int tid = threadIdx.x, wave = __builtin_amdgcn_readfirstlane(tid >> 6);
    const int G = gridDim.x, bx = blockIdx.x;
    const int vcu = (G % 8 == 0) ? (bx % 8) * (G / 8) + bx / 8 : bx;
    unsigned char* ws = a.ws; float* out = a.out;
    unsigned* ctl = (unsigned*)(ws + WS_CTL);
    if (tid < 64) MISC[tid] = 0u;
    __syncthreads();
    XcdBarrier bar = xcd_barrier_post(ctl + CW_BAR + a.region * XCD_BAR_WORDS, MISC + 8);
    const int lo = a.ph_lo, hi = a.ph_hi;
#define IN(k) (lo <= (k) && (k) < hi)
#define SEAM(k) do { if (IN(k) && IN((k) + 1)) xcd_barrier(bar, wave); } while (0)
    const int gw = vcu * NWAVES + wave, NGW = G * NWAVES;

    if (IN(PH_PREP)) { p0_prologue(a.in, ws, lds, gw, NGW, wave); }
    SEAM(PH_PREP);
    if (IN(PH_MEMKV)) {
        pg8::Gemm g{(const bf16*)(ws + WS_MB), (const bf16*)(ws + WS_WMEM), 2048, 4096, 1024}; pg8::StaticOrder S; S.init(2048, 4096, G, bx);
        EpiMemKV E{out, (bf16*)(ws + WS_KB), (bf16*)(ws + WS_VTB), (const float*)(ws + WS_SSQM)};
        pg8::gemm_phase<EpiMemKV, pg8::StaticOrder, true, true>(lds, g, S, E, wave);
    }
    SEAM(PH_MEMKV);
#pragma unroll 1
    for (int l = 0; l < 2; ++l) {
        const int pb = PH_L0 + PH_PER_LAYER * l;
        if (IN(pb + LP_G1)) {
            gate_prelude(ws, l, gw, NGW);
            for (int u = vcu; u < 256; u += G) skinny_unit<0>(ws, lds, (const bf16*)(ws + WS_XB) + (size_t)M * D, 1024, (const bf16*)(ws + WS_WIN) + (size_t)l * 2048 * 1024, 1024, u >> 5, u & 31, (float*)(ws + WS_PROJS), 2048, nullptr, wave);
            __syncthreads();
            pg8::Gemm g{(const bf16*)(ws + WS_XB), (const bf16*)(ws + WS_WIN) + (size_t)l * 2048 * 1024, M, 2048, 1024}; pg8::StaticOrder S; S.init(M, 2048, G, bx);
            EpiG1 E{(bf16*)(ws + WS_U), (bf16*)(ws + WS_VG), (bf16*)(ws + WS_XM), (bf16*)(ws + WS_OP), (const float*)(ws + WS_SSQ), (float*)(ws + WS_SSQV), out + O_CVP + (size_t)l * 12288};
            pg8::gemm_phase<EpiG1, pg8::StaticOrder, true, true>(lds, g, S, E, wave);
        }
        SEAM(pb + LP_G1);
        if (IN(pb + LP_M1)) {
            for (int u = vcu; u < 512; u += G) sample_mix_unit(a.in, ws, out, lds, l, u >> 2, u & 3, wave);
            for (int u = vcu; u < 1024; u += G) {
                if (u < 512) mlstm_local_unit(a.in, ws, lds, l, u >> 6, (u >> 4) & 3, u & 15, wave);
                else { const int v = u - 512; gmlp_unit(a.in, ws, lds, l, v >> 6, (v >> 2) & 15, v & 3, wave); }
            }
        }
        SEAM(pb + LP_M1);
        if (IN(pb + LP_M2)) {
            for (int u = vcu; u < 512; u += G) mlstm_out_unit(a.in, ws, out, lds, l, u >> 6, (u >> 4) & 3, u & 15, wave);
            __syncthreads();
        }
        SEAM(pb + LP_M2);
        if (IN(pb + LP_G2)) {
            for (int u = vcu; u < 128; u += G) skinny_unit<1>(ws, lds, (const bf16*)(ws + WS_YMIXS), 1024, (const bf16*)(ws + WS_WOUT) + (size_t)l * 1048576, 1024, u >> 4, u & 15, nullptr, 0, nullptr, wave, l == 0 ? a.in[1] : (const float*)(ws + WS_X) + (size_t)M * D);
            __syncthreads();
            pg8::Gemm g{(const bf16*)(ws + WS_YMIX), (const bf16*)(ws + WS_WOUT) + (size_t)l * 1048576, M, 1024, 1024}; pg8::StaticOrder S; S.init(M, 1024, G, bx);
            EpiResid E{l == 0 ? a.in[0] : (const float*)(ws + WS_X), (float*)(ws + WS_X), (bf16*)(ws + WS_XB), (float*)(ws + WS_SSQ)};
            pg8::gemm_phase<EpiResid, pg8::StaticOrder, true, true>(lds, g, S, E, wave);
        }
        SEAM(pb + LP_G2);
        if (IN(pb + LP_G3)) {
            for (int u = vcu; u < 128; u += G) skinny_unit<0>(ws, lds, (const bf16*)(ws + WS_XB) + (size_t)M * D, 1024, (const bf16*)(ws + WS_WCQ) + (size_t)l * 1048576, 1024, u >> 4, u & 15, (float*)(ws + WS_QS), 1024, nullptr, wave);
            __syncthreads();
            pg8::Gemm g{(const bf16*)(ws + WS_XB), (const bf16*)(ws + WS_WCQ) + (size_t)l * 1048576, M, 1024, 1024}; pg8::StaticOrder S; S.init(M, 1024, G, bx);
            EpiScaleBf16<0> E{(bf16*)(ws + WS_QA), 1024, (const float*)(ws + WS_SSQ)};
            pg8::gemm_phase<EpiScaleBf16<0>, pg8::StaticOrder, true, true>(lds, g, S, E, wave);
        }
        SEAM(pb + LP_G3);
        if (IN(pb + LP_ATT)) {
            for (int u = vcu; u < 512; u += G) sample_attn_unit(a.in, ws, lds, l, u >> 2, u & 3, wave);
            for (int u = vcu; u < 256; u += G) attn_unit(ws, lds, l, u >> 2, u & 3, wave);
            __syncthreads();
        }
        SEAM(pb + LP_ATT);
        if (IN(pb + LP_G4)) {
            for (int u = vcu; u < 128; u += G) skinny_unit<1>(ws, lds, (const bf16*)(ws + WS_ATTS), 1024, (const bf16*)(ws + WS_WCO) + (size_t)l * 1048576, 1024, u >> 4, u & 15, nullptr, 0, nullptr, wave, (const float*)(ws + WS_X) + (size_t)M * D);
            __syncthreads();
            pg8::Gemm g{(const bf16*)(ws + WS_ATT), (const bf16*)(ws + WS_WCO) + (size_t)l * 1048576, M, 1024, 1024}; pg8::StaticOrder S; S.init(M, 1024, G, bx);
            EpiResid E{(const float*)(ws + WS_X), (float*)(ws + WS_X), (bf16*)(ws + WS_XB), (float*)(ws + WS_SSQ)};
            pg8::gemm_phase<EpiResid, pg8::StaticOrder, true, true>(lds, g, S, E, wave);
        }
        SEAM(pb + LP_G4);
        if (IN(pb + LP_G5)) {
            for (int u = vcu; u < 512; u += G) skinny_unit<2>(ws, lds, (const bf16*)(ws + WS_XB) + (size_t)M * D, 1024, (const bf16*)(ws + WS_WUP) + (size_t)l * 4194304, 1024, u >> 6, u & 63, nullptr, 4096, (bf16*)(ws + WS_HMIDS), wave);
            __syncthreads();
            pg8::Gemm g{(const bf16*)(ws + WS_XB), (const bf16*)(ws + WS_WUP) + (size_t)l * 4194304, M, 4096, 1024}; pg8::StaticOrder S; S.init(M, 4096, G, bx);
            EpiScaleBf16<1> E{(bf16*)(ws + WS_HMID), 4096, (const float*)(ws + WS_SSQ)};
            pg8::gemm_phase<EpiScaleBf16<1>, pg8::StaticOrder, true, true>(lds, g, S, E, wave);
        }
        SEAM(pb + LP_G5);
        if (IN(pb + LP_G6)) {
            for (int u = vcu; u < 128; u += G) skinny_unit<1>(ws, lds, (const bf16*)(ws + WS_HMIDS), 4096, (const bf16*)(ws + WS_WDOWN) + (size_t)l * 4194304, 4096, u >> 4, u & 15, nullptr, 0, nullptr, wave, (const float*)(ws + WS_X) + (size_t)M * D);
            __syncthreads();
            pg8::Gemm g{(const bf16*)(ws + WS_HMID), (const bf16*)(ws + WS_WDOWN) + (size_t)l * 4194304, M, 1024, 4096}; pg8::StaticOrder S; S.init(M, 1024, G, bx);
            EpiResid E{(const float*)(ws + WS_X), (float*)(ws + WS_X), (bf16*)(ws + WS_XB), (float*)(ws + WS_SSQ)};
            pg8::gemm_phase<EpiResid, pg8::StaticOrder, true, true>(lds, g, S, E, wave);
        }
        SEAM(pb + LP_G6);
    }
    if (IN(PH_FINAL)) final_norm_rows((const float*)(ws + WS_X), (const float*)(ws + WS_SSQ), a.in[33], out + O_YP, out + O_YS, gw, NGW);
#undef IN
#undef SEAM
}

static int g_grid = 0;
static void launch(hipStream_t st, void* const* d_in, float* out, unsigned char* wsf, int ph_lo, int ph_hi, int region) {
    if (g_grid == 0) {
        int dev = 0, cus = 0;
        if (hipGetDevice(&dev) != hipSuccess || hipDeviceGetAttribute(&cus, hipDeviceAttributeMultiprocessorCount, dev) != hipSuccess) { fprintf(stderr, "kernel_launch: device query failed\n"); g_grid = -1; return; }
        if (hipFuncSetAttribute((const void*)fwd, hipFuncAttributeMaxDynamicSharedMemorySize, LDS_BYTES) != hipSuccess) { fprintf(stderr, "kernel_launch: hipFuncSetAttribute failed\n"); g_grid = -1; return; }
        int per_cu = 0;
        if (hipOccupancyMaxActiveBlocksPerMultiprocessor(&per_cu, (const void*)fwd, NTHR, LDS_BYTES) != hipSuccess || per_cu < 1) fprintf(stderr, "kernel_launch: occupancy query says %d\n", per_cu);
        (void)hipGetLastError();
        g_grid = cus;
    }
    if (g_grid < 0) return;
    Args a{};
    for (int i = 0; i < 34; ++i) a.in[i] = (const float*)d_in[i];
    a.out = out; a.ws = wsf; a.ph_lo = ph_lo; a.ph_hi = ph_hi; a.region = region; a.pad = 0;
    hipLaunchKernelGGL(fwd, dim3(g_grid), dim3(NTHR), LDS_BYTES, st, a);
}
}
extern "C" void kernel_launch(void* const* d_in, const int* in_sizes, int n_in, void* d_out, int out_size, void* d_ws, size_t ws_size, hipStream_t stream) {
    using namespace fk;
    if (n_in != 34 || out_size != (int)O_END || ws_size < WS_FAST_END) { fprintf(stderr, "kernel_launch: unexpected problem shape (n_in %d, out %d, ws %zu)\n", n_in, out_size, ws_size); return; }
    (void)hipMemsetAsync((unsigned char*)d_ws + WS_CTL, 0, CTL_BYTES, stream);
    fk::launch(stream, d_in, (float*)d_out, (unsigned char*)d_ws, 0, NPH, 0);
}
```

```cpp
#include <hip/hip_runtime.h>
#include <cstdio>
#include <cstdint>
namespace pg8 {
#define PG8_LAS __attribute__((address_space(3)))
typedef unsigned short bf16_t;
typedef short bf16x8 __attribute__((ext_vector_type(8)));
typedef float f32x4 __attribute__((ext_vector_type(4)));
typedef unsigned u32x4 __attribute__((ext_vector_type(4)));
constexpr int BM = 256, BK = 64, HALF = 128, HTB = HALF * BK * 2  , STAGE_BYTES = 8 * HTB, NXCD = 8, WGM = 8;

__host__ __device__ __forceinline__ int lds_byte(int r, int c) { const int st = (r >> 4) * 2 + (c >> 5), rr = r & 15, cc = c & 31, ob = rr * 64 + cc * 2; return st * 1024 + (ob ^ (((ob >> 9) & 1) << 5)); }
__host__ __device__ __forceinline__ void stage_rc(int b, int& R, int& C) { const int st = b / 1024, sb = b % 1024, swz = sb ^ (((sb >> 9) & 1) << 5); R = (st >> 1) * 16 + swz / 64; C = (st & 1) * 32 + (swz % 64) / 2; }
__host__ __device__ __forceinline__ int perm32(int rho) { const int n = rho >> 4, i = rho & 15; return 8 * (i >> 2) + 4 * n + (i & 3); }

struct Unit { int pm, pn; };
struct Gemm { const bf16_t* A; const bf16_t* Bt; int M, N, K; unsigned long long* stamps = nullptr; };

struct StaticOrder {
    int nM, nN, nwg, G, c;
    __host__ __device__ __forceinline__ void init(int M, int N, int G_, int c_) { nM = M / BM; nN = N / BM; nwg = nM * nN; G = G_; c = c_; }
    __host__ __device__ __forceinline__ bool next(int i, Unit& u) const {
        const long L = (long)i * G + c; if (L >= nwg) return false;
        int wgid = (int)L; { const int q = nwg / NXCD, r = nwg % NXCD, xcd = wgid % NXCD, off = wgid / NXCD; wgid = (xcd < r ? xcd * (q + 1) : r * (q + 1) + (xcd - r) * q) + off; }
        const int nig = WGM * nN, gid = wgid / nig, fm = gid * WGM, gsz = (nM - fm) < WGM ? (nM - fm) : WGM;
        u.pm = fm + ((wgid % nig) % gsz); u.pn = (wgid % nig) / gsz; return true;
    }
    __device__ __forceinline__ void a_ready(const Unit&) const {}
    __device__ __forceinline__ void done(const Unit&) const {}
};

__device__ __forceinline__ unsigned cvt_pk_bf16(float lo, float hi) { unsigned r; asm volatile("v_cvt_pk_bf16_f32 %0, %1, %2" : "=v"(r) : "v"(lo), "v"(hi)); return r; }
struct NoPre { __device__ __forceinline__ void operator()() const {} };
template <class Epi, class Sched, bool ALIGN_EPI = false, bool SP2 = false, class Pre = NoPre>
__device__ __forceinline__ void gemm_phase(PG8_LAS unsigned char* lds, const Gemm g, const Sched& S, const Epi& E, int wave_in, const Pre pre = Pre()) {
    int lane_o; asm volatile("v_mbcnt_lo_u32_b32 %0, -1, 0\n\tv_mbcnt_hi_u32_b32 %0, -1, %0" : "=v"(lane_o));
    const int wid = __builtin_amdgcn_readfirstlane(wave_in), lane = lane_o, tid = wid * 64 + lane, wr = wid >> 2, wc = wid & 3, fr = lane & 15, fq = lane >> 4;
    const int K = g.K, nt = K / BK;
    unsigned voffA[2], voffB[2];
#pragma unroll
    for (int i = 0; i < 2; ++i) { int R, C; stage_rc(tid * 16 + i * 8192, R, C); const int Rb = Epi::PERM ? ((R & ~31) + perm32(R & 31)) : R;
        voffA[i] = (unsigned)(R * K + C) * 2u; voffB[i] = (unsigned)(Rb * K + C) * 2u; }
    const size_t kstep = (size_t)(BK * 2);
    const size_t hstep = (size_t)HALF * K * 2;
    const size_t tstep = 2 * hstep;
    const unsigned ldsw = (unsigned)wid * 1024u;
    const int aoff = lds_byte(wr * 64 + fr, fq * 8), boff = lds_byte(wc * 32 + fr, fq * 8);
#define PG8_SA(b, h) (((b) * 2 + (h)) * HTB)
#define PG8_SB(b, h) ((4 + (b) * 2 + (h)) * HTB)
#define PG8_STAGE(bufoff, gbase, voff) do { _Pragma("unroll") for (int _i = 0; _i < 2; ++_i) \
        __builtin_amdgcn_global_load_lds((const unsigned*)((const char*)(gbase) + (voff)[_i]), (PG8_LAS unsigned*)(lds + (bufoff) + ldsw + _i * 8192), 16, 0, 0); } while (0)
#define PG8_LDA(dst, b, h) do { _Pragma("unroll") for (int m = 0; m < 4; ++m) _Pragma("unroll") for (int k = 0; k < 2; ++k) dst[m][k] = *(const PG8_LAS bf16x8*)(lds + PG8_SA(b, h) + aoff + m * 2048 + k * 1024); } while (0)
#define PG8_LDB(dst, b, h) do { _Pragma("unroll") for (int n = 0; n < 2; ++n) _Pragma("unroll") for (int k = 0; k < 2; ++k) dst[n][k] = *(const PG8_LAS bf16x8*)(lds + PG8_SB(b, h) + boff + n * 2048 + k * 1024); } while (0)
#define PG8_MMA(ai, bj, At, Bt) do { __builtin_amdgcn_s_setprio(1); _Pragma("unroll") for (int m = 0; m < 4; ++m) _Pragma("unroll") for (int n = 0; n < 2; ++n) _Pragma("unroll") for (int k = 0; k < 2; ++k) \
        acc[ai][bj][m][n] = __builtin_amdgcn_mfma_f32_16x16x32_bf16(Bt[n][k], At[m][k], acc[ai][bj][m][n], 0, 0, 0); __builtin_amdgcn_s_setprio(0); } while (0)
#define PG8_WAIT_V(n) asm volatile("s_waitcnt vmcnt(" #n ")" ::: "memory")
#define PG8_WAIT_L(n) asm volatile("s_waitcnt lgkmcnt(" #n ")" ::: "memory")
#define PG8_BAR __builtin_amdgcn_s_barrier()
#define PG8_SCHED __builtin_amdgcn_sched_barrier(0)
    Unit cur, nxt; int ui = 0;
    if (!S.next(0, cur)) return;
    f32x4 acc[2][2][4][2];
#pragma unroll
    for (int a = 0; a < 2; ++a)
#pragma unroll
        for (int b = 0; b < 2; ++b)
#pragma unroll
            for (int m = 0; m < 4; ++m)
#pragma unroll
                for (int n = 0; n < 2; ++n) acc[a][b][m][n] = (f32x4){0.f, 0.f, 0.f, 0.f};
    bf16x8 At[4][2], B0[2][2], B1[2][2];
    const char* cA = (const char*)g.A + (size_t)cur.pm * tstep; const char* cB = (const char*)g.Bt + (size_t)cur.pn * tstep;
    S.a_ready(cur);
    if constexpr (SP2) {
        PG8_STAGE(PG8_SB(0, 0), cB, voffB); PG8_STAGE(PG8_SB(0, 1), cB + hstep, voffB); PG8_STAGE(PG8_SA(0, 0), cA, voffA); PG8_STAGE(PG8_SA(0, 1), cA + hstep, voffA);
        pre();
        if (wr == 1) PG8_BAR;
        PG8_WAIT_V(2); PG8_BAR;
        PG8_STAGE(PG8_SB(1, 0), cB + kstep, voffB); PG8_STAGE(PG8_SA(1, 0), cA + kstep, voffA); PG8_STAGE(PG8_SB(1, 1), cB + hstep + kstep, voffB);
        PG8_WAIT_V(6); PG8_BAR;
    } else {
        PG8_STAGE(PG8_SB(0, 0), cB, voffB); PG8_STAGE(PG8_SA(0, 0), cA, voffA); PG8_STAGE(PG8_SB(0, 1), cB + hstep, voffB); PG8_STAGE(PG8_SA(0, 1), cA + hstep, voffA);
        if (wr == 1) PG8_BAR;
        PG8_WAIT_V(4); PG8_BAR;
        PG8_STAGE(PG8_SB(1, 0), cB + kstep, voffB); PG8_STAGE(PG8_SA(1, 0), cA + kstep, voffA); PG8_STAGE(PG8_SB(1, 1), cB + hstep + kstep, voffB);
        PG8_WAIT_V(6); PG8_BAR;
    }
    for (;;) {
        const bool has_next = S.next(ui + 1, nxt);
        const char* nA = has_next ? (const char*)g.A + (size_t)nxt.pm * tstep : cA; const char* nB = has_next ? (const char*)g.Bt + (size_t)nxt.pn * tstep : cB;
        for (int t = 0; t < nt; t += 2) {
            const bool last = (t == nt - 2);
            const char* a1 = cA + (size_t)(t + 1) * kstep;
            const char* a2 = last ? nA : cA + (size_t)(t + 2) * kstep; const char* b2 = last ? nB : cB + (size_t)(t + 2) * kstep;
            const char* a3 = a2 + kstep; const char* b3 = b2 + kstep;
            if (last && has_next) S.a_ready(nxt);
            if constexpr (SP2) {
            PG8_LDB(B0, 0, 0); PG8_LDB(B1, 0, 1); PG8_SCHED; PG8_LDA(At, 0, 0); PG8_STAGE(PG8_SA(1, 1), a1 + hstep, voffA);
            PG8_WAIT_V(8); PG8_WAIT_L(0); PG8_BAR; PG8_MMA(0, 0, At, B0); PG8_MMA(0, 1, At, B1); PG8_BAR; PG8_SCHED;
            PG8_LDA(At, 0, 1); PG8_STAGE(PG8_SB(0, 0), b2, voffB); PG8_STAGE(PG8_SB(0, 1), b2 + hstep, voffB); PG8_STAGE(PG8_SA(0, 0), a2, voffA);
            PG8_WAIT_V(8); PG8_WAIT_L(0); PG8_BAR; PG8_MMA(1, 0, At, B0); PG8_MMA(1, 1, At, B1); PG8_BAR; PG8_SCHED;
            PG8_LDB(B0, 1, 0); PG8_LDB(B1, 1, 1); PG8_SCHED; PG8_LDA(At, 1, 0); PG8_STAGE(PG8_SA(0, 1), a2 + hstep, voffA);
            PG8_WAIT_V(8); PG8_WAIT_L(0); PG8_BAR; PG8_MMA(0, 0, At, B0); PG8_MMA(0, 1, At, B1); PG8_BAR; PG8_SCHED;
            PG8_LDA(At, 1, 1); PG8_STAGE(PG8_SB(1, 0), b3, voffB); PG8_STAGE(PG8_SB(1, 1), b3 + hstep, voffB); PG8_STAGE(PG8_SA(1, 0), a3, voffA);
            PG8_WAIT_V(8); PG8_WAIT_L(0); PG8_BAR; PG8_MMA(1, 0, At, B0); PG8_MMA(1, 1, At, B1); PG8_BAR; PG8_SCHED;
            } else {
            PG8_LDB(B0, 0, 0); PG8_SCHED; PG8_LDA(At, 0, 0); PG8_STAGE(PG8_SA(1, 1), a1 + hstep, voffA);
            PG8_WAIT_L(8); PG8_BAR; PG8_WAIT_L(0); PG8_MMA(0, 0, At, B0); PG8_BAR; PG8_SCHED;
            PG8_LDB(B1, 0, 1); PG8_STAGE(PG8_SB(0, 0), b2, voffB);
            PG8_BAR; PG8_WAIT_L(0); PG8_MMA(0, 1, At, B1); PG8_BAR;
            PG8_LDA(At, 0, 1); PG8_STAGE(PG8_SA(0, 0), a2, voffA);
            PG8_BAR; PG8_WAIT_L(0); PG8_MMA(1, 0, At, B0); PG8_BAR; PG8_SCHED;
            PG8_STAGE(PG8_SB(0, 1), b2 + hstep, voffB);
            PG8_WAIT_V(6); PG8_BAR; PG8_MMA(1, 1, At, B1); PG8_BAR;
            PG8_LDB(B0, 1, 0); PG8_SCHED; PG8_LDA(At, 1, 0); PG8_STAGE(PG8_SA(0, 1), a2 + hstep, voffA);
            PG8_WAIT_L(8); PG8_BAR; PG8_WAIT_L(0); PG8_MMA(0, 0, At, B0); PG8_BAR; PG8_SCHED;
            PG8_LDB(B1, 1, 1); PG8_STAGE(PG8_SB(1, 0), b3, voffB);
            PG8_BAR; PG8_WAIT_L(0); PG8_MMA(0, 1, At, B1); PG8_BAR;
            PG8_LDA(At, 1, 1); PG8_STAGE(PG8_SA(1, 0), a3, voffA);
            PG8_BAR; PG8_WAIT_L(0); PG8_MMA(1, 0, At, B0); PG8_BAR; PG8_SCHED;
            PG8_STAGE(PG8_SB(1, 1), b3 + hstep, voffB);
            PG8_WAIT_V(6); PG8_BAR; PG8_MMA(1, 1, At, B1); PG8_BAR;
            }
        }
#ifdef FK_STAMPS
        if (g.stamps && blockIdx.x == 0 && wid == 0 && lane == 0 && ui < 8) g.stamps[2 * ui] = __builtin_amdgcn_s_memrealtime();
#endif
        if constexpr (ALIGN_EPI) { if (wr == 0) PG8_BAR; }
        if constexpr (!Epi::AFTER_DRAIN) { E(acc, cur, wr, wc, fr, fq); S.done(cur); }
#ifdef FK_STAMPS
        if (g.stamps && blockIdx.x == 0 && wid == 0 && lane == 0 && ui < 8) g.stamps[2 * ui + 1] = __builtin_amdgcn_s_memrealtime();
#endif
        if (!has_next) break;
#pragma unroll
        for (int a = 0; a < 2; ++a)
#pragma unroll
            for (int b = 0; b < 2; ++b)
#pragma unroll
                for (int m = 0; m < 4; ++m)
#pragma unroll
                    for (int n = 0; n < 2; ++n) acc[a][b][m][n] = (f32x4){0.f, 0.f, 0.f, 0.f};
        cur = nxt; cA = nA; cB = nB; ++ui;
        if constexpr (ALIGN_EPI) { if (wr == 1) PG8_BAR; }
    }
    PG8_WAIT_V(0);
    if constexpr (!ALIGN_EPI) { if (wr == 0) PG8_BAR; }
    PG8_BAR;
    if constexpr (Epi::AFTER_DRAIN) { E.fused(acc, cur, wr, wc, fr, fq, lds, wid, lane); S.done(cur); }
#undef PG8_SA
#undef PG8_SB
#undef PG8_STAGE
#undef PG8_LDA
#undef PG8_LDB
#undef PG8_MMA
#undef PG8_WAIT_V
#undef PG8_WAIT_L
#undef PG8_BAR
#undef PG8_SCHED
}
}
namespace fk {
#define GAS __attribute__((address_space(1)))
#define LAS __attribute__((address_space(3)))
typedef unsigned short bf16;
typedef unsigned v4u __attribute__((ext_vector_type(4)));
typedef unsigned v2u __attribute__((ext_vector_type(2)));
typedef float f32x4 __attribute__((ext_vector_type(4)));
typedef float f32x2 __attribute__((ext_vector_type(2)));
typedef short bf16x8 __attribute__((ext_vector_type(8)));
typedef short bf16x4 __attribute__((ext_vector_type(4)));
#define LDS_WAIT() asm volatile("s_waitcnt lgkmcnt(0)" ::: "memory")
#define VM_WAIT() asm volatile("s_waitcnt vmcnt(0)" ::: "memory")
#define LBAR() do { asm volatile("s_waitcnt lgkmcnt(0)" ::: "memory"); __builtin_amdgcn_s_barrier(); asm volatile("" ::: "memory"); } while (0)

constexpr int NWAVES = 8, NTHR = 512;
constexpr int M = 16384, MS = 128, MT = M + MS, D = 1024, FF = 4096, NIN = 2056, SEQ = 2048, NB = 8;
constexpr float EPS = 1e-6f;
constexpr size_t O_YP = 0, O_YS = 16777216, O_MK = 16908288, O_MV = 21102592, O_CP = 25296896, O_NP = 26345472, O_MP = 26353664, O_CVP = 26353728,
                 O_CS = 26378304, O_NS = 43155520, O_MS = 43286592, O_CVS = 43287616, O_GV = 43680832, O_END = 43811904;
constexpr size_t MiB = 1u << 20;
constexpr size_t WS_CTL = 0, CTL_BYTES = 1 * MiB;
constexpr size_t WS_WG = 1 * MiB;
constexpr size_t WS_HW = 2 * MiB;
constexpr size_t WS_WIN = 4 * MiB, WS_WOUT = 12 * MiB, WS_WCQ = 16 * MiB, WS_WCO = 20 * MiB, WS_WUP = 24 * MiB, WS_WDOWN = 40 * MiB, WS_WMEM = 56 * MiB;
constexpr size_t WS_MB = 64 * MiB, WS_SSQM = 68 * MiB, WS_KB = 70 * MiB, WS_VTB = 78 * MiB;
constexpr size_t WS_XB = 86 * MiB, WS_X = 119 * MiB, WS_SSQ = 184 * MiB, WS_SSQV = 186 * MiB, WS_GATES = 187 * MiB, WS_BT = 188 * MiB, WS_UNITS = 189 * MiB;
constexpr size_t WS_TMP = 190 * MiB, TMP_BSTRIDE = 7340032;
constexpr size_t WS_U = WS_TMP, WS_VG = WS_TMP + 2 * MiB, WS_XM = WS_TMP + 4 * MiB, WS_OP = WS_TMP + 6 * MiB, WS_Q = WS_TMP + 8 * MiB, WS_KP = WS_TMP + 10 * MiB, WS_CONV = WS_TMP + 12 * MiB, WS_VT = WS_TMP + 14 * MiB;
constexpr size_t WS_UEXT = 318 * MiB, WS_YMIX = 354 * MiB, WS_QA = WS_YMIX  , WS_ATT = WS_QA;
constexpr size_t WS_SAMP = 450 * MiB, WS_HMID = WS_TMP  , WS_FAST_END = 470 * MiB;
constexpr size_t WS_CPRE = 119 * MiB;
constexpr int CW_TMO = 0, CW_XID = 1024  , CW_LCNT = 2048  , CW_BAR = 4096;
constexpr int RING_BYTES = 131072, LDS_BYTES = 155648  , MISC_OFF = 155648 - 256;

__device__ __forceinline__ unsigned f2bf(float f) { unsigned u = __builtin_bit_cast(unsigned, f); return (u + 0x7fffu + ((u >> 16) & 1u)) >> 16; }
__device__ __forceinline__ unsigned pk2(float lo, float hi) { return f2bf(lo) | (f2bf(hi) << 16); }
typedef float f32x2_t __attribute__((ext_vector_type(2)));
typedef __bf16 bf16x2_t __attribute__((ext_vector_type(2)));
__device__ __forceinline__ unsigned cvtpk(float lo, float hi) { f32x2_t v = {lo, hi}; bf16x2_t b = __builtin_convertvector(v, bf16x2_t); return __builtin_bit_cast(unsigned, b); }
__device__ __forceinline__ int lane_id_asm() { int l; asm volatile("v_mbcnt_lo_u32_b32 %0, -1, 0\n\tv_mbcnt_hi_u32_b32 %0, -1, %0" : "=v"(l)); return l; }
__device__ __forceinline__ float bf2f(unsigned short b) { return __builtin_bit_cast(float, (unsigned)b << 16); }
__device__ __forceinline__ float wave_sum(float v) {
#pragma unroll
    for (int o = 1; o < 64; o <<= 1) v += __shfl_xor(v, o);
    return v;
}
constexpr float GELU_A = -2.302208198f, GELU_B = -0.102943240f;
__device__ __forceinline__ float gelu_f(float x) { const float z = x * __builtin_fmaf(GELU_B, x * x, GELU_A); return x * __builtin_amdgcn_rcpf(1.f + __builtin_amdgcn_exp2f(z)); }
__device__ __forceinline__ f32x4 gelu4(const f32x4 x) {
    const f32x4 z = x * (x * x * GELU_B + GELU_A); f32x4 e;
#pragma unroll
    for (int i = 0; i < 4; ++i) e[i] = __builtin_amdgcn_exp2f(z[i]);
    e = e + 1.f; f32x4 r;
#pragma unroll
    for (int i = 0; i < 4; ++i) r[i] = __builtin_amdgcn_rcpf(e[i]);
    return x * r;
}

#define XB_TMO      128
#define XB_XCNT(j)  (256  + 64 * (j))
#define XB_XSUB(j)  (1280 + 64 * (j))
#define XB_XGEN(j)  (2304 + 64 * (j))
#define XB_TOP      3328
#define XB_TOPGEN   3392
#define XCD_BAR_WORDS 3456
#define XB_SPIN_CAP (1u << 20)
__device__ __forceinline__ unsigned xb_ld(unsigned* p)              { return __hip_atomic_load(p, __ATOMIC_RELAXED, __HIP_MEMORY_SCOPE_AGENT); }
__device__ __forceinline__ unsigned xb_add(unsigned* p, unsigned v) { return __hip_atomic_fetch_add(p, v, __ATOMIC_RELAXED, __HIP_MEMORY_SCOPE_AGENT); }
__device__ __forceinline__ unsigned xb_xcc_id() { return (unsigned)__builtin_amdgcn_s_getreg((3 << 11) | 20) & 0xFu; }
#define XB_SPIN(cond, bar) do { unsigned _sp = 0; while (cond) { __builtin_amdgcn_s_sleep(1); \
    if ((++_sp & 255u) == 0u) { if (xb_ld(&(bar)[XB_TMO])) break; if (_sp > XB_SPIN_CAP) { atomicAdd(&(bar)[XB_TMO], 1u); break; } } } } while (0)
struct XcdBarrier { unsigned* bar; unsigned x; volatile LAS unsigned* st; };
__device__ __forceinline__ XcdBarrier xcd_barrier_post(unsigned* bar, volatile LAS unsigned* st) {
    XcdBarrier b; b.bar = bar; b.x = xb_xcc_id(); b.st = st;
    if (threadIdx.x == 0) (void)xb_add(&bar[XB_XCNT(b.x)], 1u);
    return b;
}
__device__ __forceinline__ void xcd_barrier_complete(unsigned* bar, unsigned x, unsigned& nloc, unsigned& nx) {
    const unsigned G = gridDim.x * gridDim.y * gridDim.z;
    unsigned sum, cnt, mine, sp = 0u;
    for (;;) {
        sum = 0u; cnt = 0u; mine = 0u;
#pragma unroll
        for (unsigned j = 0; j < 16; ++j) { const unsigned c = xb_ld(&bar[XB_XCNT(j)]); sum += c; cnt += (c > 0u) ? 1u : 0u; mine = (j == x) ? c : mine; }
        if (sum == G) break;
        __builtin_amdgcn_s_sleep(1);
        if ((++sp & 255u) == 0u) { if (xb_ld(&bar[XB_TMO])) break; if (sp > XB_SPIN_CAP) { atomicAdd(&bar[XB_TMO], 1u); break; } }
    }
    nloc = mine > 0u ? mine : 1u; nx = cnt > 0u ? cnt : 1u;
}
__device__ __forceinline__ void xcd_barrier(const XcdBarrier& b, int wave) {
    asm volatile("s_waitcnt vmcnt(0)" ::: "memory");
    __syncthreads();
    if (wave == 0 && lane_id_asm() == 0) {
        unsigned* bar = b.bar;
        __builtin_amdgcn_s_waitcnt(0);
        unsigned nloc = b.st[0], nx = b.st[1];
        if (nloc == 0u) { xcd_barrier_complete(bar, b.x, nloc, nx); b.st[0] = nloc; b.st[1] = nx; }
        const unsigned old = xb_add(&bar[XB_XSUB(b.x)], 1u);
        const unsigned gen = old / nloc;
        if (old + 1u == (gen + 1u) * nloc) {
            __builtin_amdgcn_fence(__ATOMIC_RELEASE, "agent");
            asm volatile("s_waitcnt vmcnt(0)" ::: "memory");
            const unsigned og = xb_add(&bar[XB_TOP], 1u);
            const unsigned tg = og / nx;
            if (og + 1u == (tg + 1u) * nx) xb_add(&bar[XB_TOPGEN], 1u);
            else XB_SPIN(xb_ld(&bar[XB_TOPGEN]) == tg, bar);
            __builtin_amdgcn_fence(__ATOMIC_ACQUIRE, "agent");
            xb_add(&bar[XB_XGEN(b.x)], 1u);
            asm volatile("s_waitcnt vmcnt(0)" ::: "memory");
        } else {
            XB_SPIN(xb_ld(&bar[XB_XGEN(b.x)]) == gen, bar);
            __builtin_amdgcn_fence(__ATOMIC_ACQUIRE, "agent");
            asm volatile("s_waitcnt vmcnt(0)" ::: "memory");
        }
    }
    __syncthreads();
}
__device__ __forceinline__ void xcd_local_barrier(unsigned* ctl, unsigned* bar, int xg, volatile LAS unsigned* st, int wave) {
    asm volatile("s_waitcnt vmcnt(0)" ::: "memory");
    __syncthreads();
    if (wave == 0 && lane_id_asm() == 0) {
        unsigned* c = ctl + CW_LCNT + 64 * xg;
        const unsigned k = st[3]; st[3] = k + 1u;
        (void)xb_add(c, 1u);
        __builtin_amdgcn_fence(__ATOMIC_ACQUIRE, "agent");
        const unsigned target = 32u * (k + 1u);
        XB_SPIN(xb_ld(c) < target, bar);
        asm volatile("s_waitcnt vmcnt(0)" ::: "memory");
    }
    __syncthreads();
}
}
namespace fk {
__device__ __forceinline__ void tr_item(const float* __restrict__ W, int ldw, int K, int N, bf16* WT, const float* __restrict__ gain, float alpha, LAS float* scr, int item, int lane) {
    const int nblk = N / 32, kb = item / nblk, nb = item % nblk, k0 = 64 * kb, n0 = 32 * nb;
    float wv[32];
#pragma unroll
    for (int i = 0; i < 32; ++i) wv[i] = W[(size_t)(k0 + 2 * i + (lane >> 5)) * ldw + n0 + (lane & 31)];
#pragma unroll
    for (int i = 0; i < 32; ++i) { const int kk = 2 * i + (lane >> 5); const float g = gain ? gain[k0 + kk] * alpha : alpha; scr[kk * 33 + (lane & 31)] = wv[i] * g; }
    LDS_WAIT(); asm volatile("" ::: "memory");
    const int c = lane & 7;
#pragma unroll
    for (int j = 0; j < 4; ++j) { const int n = (lane >> 3) + 8 * j; const LAS float* s = scr + (8 * c) * 33 + n;
        v4u o; o.x = pk2(s[0 * 33], s[1 * 33]); o.y = pk2(s[2 * 33], s[3 * 33]); o.z = pk2(s[4 * 33], s[5 * 33]); o.w = pk2(s[6 * 33], s[7 * 33]);
        *(GAS v4u*)(WT + (size_t)(n0 + n) * K + k0 + 8 * c) = o; }
    LDS_WAIT(); asm volatile("" ::: "memory");
}
__device__ __forceinline__ float row_to_bf16(const float* xrow, bf16* orow, int lane) {
    const GAS f32x4* xr = (const GAS f32x4*)xrow + lane;
    f32x4 v[4]; float s = 0.f;
#pragma unroll
    for (int j = 0; j < 4; ++j) { v[j] = xr[64 * j]; s += (v[j].x * v[j].x + v[j].y * v[j].y) + (v[j].z * v[j].z + v[j].w * v[j].w); }
    s = wave_sum(s);
    GAS unsigned long long* o8 = (GAS unsigned long long*)orow + lane;
#pragma unroll
    for (int j = 0; j < 4; ++j) o8[64 * j] = (unsigned long long)pk2(v[j].x, v[j].y) | ((unsigned long long)pk2(v[j].z, v[j].w) << 32);
    return s;
}
struct PrepJob { const float* W; int ldw, K, N; bf16* WT; const float* gain; float alpha; int items; };
template <int PART> __device__ __forceinline__ void p0_prologue(const float* const* in, unsigned char* ws, LAS unsigned char* lds, int gw, int NGW, int wave) {
    const int lane = lane_id_asm();
    int base = 0;
    LAS float* scr = (LAS float*)(lds + wave * 16384);
    for (int l = 0; l < 2; ++l) {
        const float* g_mix = in[9] + l * 1024; const float* g_mem = in[24] + l * 1024; const float* g_xa = in[27] + l * 1024; const float* g_ffn = in[30] + l * 1024;
        PrepJob jobs[8];
        jobs[0] = PrepJob{in[10] + (size_t)l * 1024 * NIN, NIN, 1024, 2048, (bf16*)(ws + WS_WIN) + (size_t)l * 2048 * 1024, g_mix, 1.f, 0};
        jobs[1] = PrepJob{in[23] + (size_t)l * 1048576, 1024, 1024, 1024, (bf16*)(ws + WS_WOUT) + (size_t)l * 1048576, nullptr, 1.f, 0};
        jobs[2] = PrepJob{in[28] + (size_t)l * 1048576, 1024, 1024, 1024, (bf16*)(ws + WS_WCQ) + (size_t)l * 1048576, g_xa, 0.0625f, 0};
        jobs[3] = PrepJob{in[29] + (size_t)l * 1048576, 1024, 1024, 1024, (bf16*)(ws + WS_WCO) + (size_t)l * 1048576, nullptr, 1.f, 0};
        jobs[4] = PrepJob{in[31] + (size_t)l * 4194304, 4096, 1024, 4096, (bf16*)(ws + WS_WUP) + (size_t)l * 4194304, g_ffn, 1.f, 0};
        jobs[5] = PrepJob{in[32] + (size_t)l * 4194304, 1024, 4096, 1024, (bf16*)(ws + WS_WDOWN) + (size_t)l * 4194304, nullptr, 1.f, 0};
        jobs[6] = PrepJob{in[25] + (size_t)l * 1048576, 1024, 1024, 1024, (bf16*)(ws + WS_WMEM) + (size_t)l * 2097152, g_mem, 1.f, 0};
        jobs[7] = PrepJob{in[26] + (size_t)l * 1048576, 1024, 1024, 1024, (bf16*)(ws + WS_WMEM) + (size_t)l * 2097152 + 1048576, g_mem, 1.f, 0};
#pragma unroll
        for (int j = 0; j < 8; ++j) {
            const bool early = (j == 0 && l == 0) || j >= 6;
            if (early != (PART == 0)) continue;
            const int items = (jobs[j].K / 64) * (jobs[j].N / 32);
            { int first = gw - (base % NGW); if (first < 0) first += NGW;
              for (int it = first; it < items; it += NGW) tr_item(jobs[j].W, jobs[j].ldw, jobs[j].K, jobs[j].N, jobs[j].WT, jobs[j].gain, jobs[j].alpha, scr, it, lane);
              base += items; }
        }
        if (PART == 1) continue;
        int firsth = gw - (base % NGW); if (firsth < 0) firsth += NGW; base += 96;
        for (int it = firsth; it < 96; it += NGW) { const int mat = it >> 3, sub = it & 7, which = mat >> 2, h = mat & 3;
            const float* W = in[16 + which] + (size_t)l * 65536 + (size_t)h * 16384;
            bf16* WT = (bf16*)(ws + WS_HW) + ((size_t)(l * 3 + which) * 4 + h) * 16384;
            tr_item(W, 128, 128, 128, WT, nullptr, which == 1 ? 0.08838834764831845f : 1.f, scr, sub, lane); }
        for (int i = gw * 64 + lane; i < 16384; i += NGW * 64) { const int c = i >> 10, k = i & 1023;
            ((bf16*)(ws + WS_WG + 65536))[l * 16384 + i] = c < 8 ? (bf16)f2bf(in[10][(size_t)l * 1024 * NIN + (size_t)k * NIN + 2048 + c] * g_mix[k]) : (bf16)0; }
        for (int i = gw * 64 + lane; i < 8192; i += NGW * 64) { const int c = i >> 10, k = i & 1023;
            ((float*)(ws + WS_WG))[l * 8192 + i] = in[10][(size_t)l * 1024 * NIN + (size_t)k * NIN + 2048 + c] * g_mix[k]; }
    }
    if (PART == 1) return;
    bf16* XB = (bf16*)(ws + WS_XB); float* SSQ = (float*)(ws + WS_SSQ);
    for (int r = gw; r < MT; r += 4 * NGW) {
        int rr[4]; f32x4 v[4][4];
#pragma unroll
        for (int k = 0; k < 4; ++k) { rr[k] = (r + k * NGW < MT) ? r + k * NGW : r;
            const float* src = rr[k] < M ? in[0] + (size_t)rr[k] * D : in[1] + (size_t)(rr[k] - M) * D; const GAS f32x4* xp = (const GAS f32x4*)src + lane;
#pragma unroll
            for (int j = 0; j < 4; ++j) v[k][j] = xp[64 * j]; }
        asm volatile("" ::: "memory");
#pragma unroll
        for (int k = 0; k < 4; ++k) { if (k > 0 && rr[k] == r) continue;
            float sa = 0.f;
#pragma unroll
            for (int j = 0; j < 4; ++j) sa += (v[k][j].x * v[k][j].x + v[k][j].y * v[k][j].y) + (v[k][j].z * v[k][j].z + v[k][j].w * v[k][j].w);
            sa = wave_sum(sa);
            GAS unsigned long long* oa = (GAS unsigned long long*)(XB + (size_t)rr[k] * D) + lane;
#pragma unroll
            for (int j = 0; j < 4; ++j) oa[64 * j] = (unsigned long long)pk2(v[k][j].x, v[k][j].y) | ((unsigned long long)pk2(v[k][j].z, v[k][j].w) << 32);
            if (lane < 16) SSQ[(size_t)rr[k] * 16 + lane] = lane == 0 ? sa : 0.f; }
    }
    for (int r = gw; r < 2048; r += NGW) {
        const float s = row_to_bf16(in[2] + (size_t)r * D, (bf16*)(ws + WS_MB) + (size_t)r * D, lane);
        if (lane == 0) ((float*)(ws + WS_SSQM))[r] = s;
    }
}
}
namespace fk {
using pg8::Unit;
__device__ __forceinline__ float rstd16(const float* SSQ, int row) {
    const f32x4* p = (const f32x4*)(SSQ + (size_t)row * 16); const f32x4 a = p[0], b = p[1], c = p[2], d = p[3];
    const float s = ((a.x + a.y) + (a.z + a.w)) + ((b.x + b.y) + (b.z + b.w)) + ((c.x + c.y) + (c.z + c.w)) + ((d.x + d.y) + (d.z + d.w));
    return rsqrtf(s * (1.f / 1024.f) + EPS);
}
constexpr int RT_OFF = RING_BYTES;
template <class Sched> __device__ __forceinline__ void rstd_table_fill(LAS unsigned char* lds, const Sched& S, const float* SSQ, int wave) {
    const int tid = wave * 64 + lane_id_asm(); LAS float* tab = (LAS float*)(lds + RT_OFF); LAS int* dir = (LAS int*)(lds + RT_OFF + 4096);
    Unit u;
#pragma unroll
    for (int j = 0; j < 2; ++j) { const int i = 2 * j + (tid >> 8);
        if (S.next(i, u)) { tab[i * 256 + (tid & 255)] = rstd16(SSQ, u.pm * 256 + (tid & 255)); if ((tid & 255) == 0) dir[i] = u.pm; }
        else if ((tid & 255) == 0) dir[i] = -1; }
    LBAR();
}
__device__ __forceinline__ const LAS float* rstd_table_rows(LAS unsigned char* lds, int pm) {
    const LAS int* dir = (const LAS int*)(lds + RT_OFF + 4096); int slot = 0;
#pragma unroll
    for (int q = 1; q < 4; ++q) if (dir[q] == pm) slot = q;
    if (dir[0] == pm) slot = 0;
    return (const LAS float*)(lds + RT_OFF) + slot * 256;
}
__device__ __forceinline__ v4u pack8(const f32x4 a, const f32x4 b) { v4u w; w.x = cvtpk(a[0], a[1]); w.y = cvtpk(a[2], a[3]); w.z = cvtpk(b[0], b[1]); w.w = cvtpk(b[2], b[3]); return w; }

struct EpiMemKV {
    static constexpr bool PERM = false, AFTER_DRAIN = false;
    float* out; bf16* KB; bf16* VTB; const float* SSQM;
    __device__ __forceinline__ void operator()(const f32x4 (&acc)[2][2][4][2], const Unit& u, int wr, int wc, int fr, int fq) const {
        const int l = u.pn >> 3, isv = (u.pn >> 2) & 1, colt = (u.pn & 3) * 256 + wc * 32 + 4 * fq;
        float* o32 = out + (isv ? O_MV : O_MK) + (size_t)l * 2097152;
#pragma unroll
        for (int ai = 0; ai < 2; ++ai)
#pragma unroll
            for (int m = 0; m < 4; ++m) { const int row = u.pm * 256 + ai * 128 + wr * 64 + m * 16 + fr;
                const float rs = rsqrtf(SSQM[row] * (1.f / 1024.f) + EPS);
#pragma unroll
                for (int bj = 0; bj < 2; ++bj)
#pragma unroll
                    for (int n = 0; n < 2; ++n) { const int col = colt + bj * 128 + n * 16; const f32x4 v = acc[ai][bj][m][n] * rs;
                        *(f32x4*)(o32 + (size_t)row * 1024 + col) = v;
                        if (!isv) { v2u w; w.x = cvtpk(v[0], v[1]); w.y = cvtpk(v[2], v[3]); *(v2u*)(KB + (size_t)l * 2097152 + (size_t)row * 1024 + col) = w; }
                        else { const int b = row >> 8, mm = row & 255;
#pragma unroll
                            for (int e = 0; e < 4; ++e) { const int c = col + e, h = c >> 8, d = c & 255;
                                VTB[(((size_t)(l * 32 + b * 4 + h)) * 256 + d) * 256 + mm] = (bf16)f2bf(v[e]); } } } }
    }
};
struct EpiG1 {
    static constexpr bool PERM = true, AFTER_DRAIN = false;
    bf16 *U, *VG, *XM, *OP; LAS unsigned char* lds; float* SSQV; float* convout;
    __device__ __forceinline__ void operator()(const f32x4 (&acc)[2][2][4][2], const Unit& u, int wr, int wc, int fr, int fq) const {
        const int t = u.pn >> 1; bf16* base = (t == 0 ? U : (t == 1 ? VG : (t == 2 ? XM : OP))) + (size_t)(u.pm >> 3) * TMP_BSTRIDE;
        const int colb = (u.pn & 1) * 256 + wc * 32 + 8 * fq; const LAS float* rt = rstd_table_rows(lds, u.pm);
#pragma unroll
        for (int ai = 0; ai < 2; ++ai)
#pragma unroll
            for (int m = 0; m < 4; ++m) { const int rl = ai * 128 + wr * 64 + m * 16 + fr, row = u.pm * 256 + rl;
                const float rs = rt[rl]; float ss = 0.f;
#pragma unroll
                for (int bj = 0; bj < 2; ++bj) { f32x4 v0 = acc[ai][bj][m][0] * rs, v1 = acc[ai][bj][m][1] * rs;
                    if (t < 2) { v0 = gelu4(v0); v1 = gelu4(v1);
                        if (t == 1) ss += ((v0[0] * v0[0] + v0[1] * v0[1]) + (v0[2] * v0[2] + v0[3] * v0[3])) + ((v1[0] * v1[0] + v1[1] * v1[1]) + (v1[2] * v1[2] + v1[3] * v1[3])); }
                    *(v4u*)(base + (size_t)row * 512 + colb + bj * 128) = pack8(v0, v1);
                    if (t == 2 && (row & 2047) >= 2045) { float* cp = convout + (size_t)(row >> 11) * 1536 + (size_t)((row & 2047) - 2045) * 512 + colb + bj * 128;
                        *(f32x4*)cp = v0; *(f32x4*)(cp + 4) = v1; } }
                if (t == 1) { ss += __shfl_xor(ss, 16); ss += __shfl_xor(ss, 32); if (fq == 0) SSQV[(size_t)row * 8 + (u.pn & 1) * 4 + wc] = ss; }
                __builtin_amdgcn_sched_barrier(0); }
    }
};
struct EpiResid {
    static constexpr bool PERM = true, AFTER_DRAIN = false;
    bf16* XB; float* SSQ;
    __device__ __forceinline__ void operator()(const f32x4 (&acc)[2][2][4][2], const Unit& u, int wr, int wc, int fr, int fq) const {
        const int colb = u.pn * 256 + wc * 32 + 8 * fq;
#pragma unroll
        for (int ai = 0; ai < 2; ++ai) {
            v4u xo[4][2];
#pragma unroll
            for (int m = 0; m < 4; ++m) { const size_t row = (size_t)(u.pm * 256 + ai * 128 + wr * 64 + m * 16 + fr);
#pragma unroll
                for (int bj = 0; bj < 2; ++bj) xo[m][bj] = *(const v4u*)(XB + row * 1024 + colb + bj * 128); }
            asm volatile("" ::: "memory");
#pragma unroll
            for (int m = 0; m < 4; ++m) { const size_t row = (size_t)(u.pm * 256 + ai * 128 + wr * 64 + m * 16 + fr); float ss = 0.f;
#pragma unroll
                for (int bj = 0; bj < 2; ++bj) { f32x4 v0 = acc[ai][bj][m][0], v1 = acc[ai][bj][m][1]; const v4u x = xo[m][bj];
                    v0[0] += __builtin_bit_cast(float, x[0] << 16); v0[1] += __builtin_bit_cast(float, x[0] & 0xffff0000u); v0[2] += __builtin_bit_cast(float, x[1] << 16); v0[3] += __builtin_bit_cast(float, x[1] & 0xffff0000u);
                    v1[0] += __builtin_bit_cast(float, x[2] << 16); v1[1] += __builtin_bit_cast(float, x[2] & 0xffff0000u); v1[2] += __builtin_bit_cast(float, x[3] << 16); v1[3] += __builtin_bit_cast(float, x[3] & 0xffff0000u);
                    *(v4u*)(XB + row * 1024 + colb + bj * 128) = pack8(v0, v1);
                    ss += ((v0[0] * v0[0] + v0[1] * v0[1]) + (v0[2] * v0[2] + v0[3] * v0[3])) + ((v1[0] * v1[0] + v1[1] * v1[1]) + (v1[2] * v1[2] + v1[3] * v1[3])); }
                ss += __shfl_xor(ss, 16); ss += __shfl_xor(ss, 32); if (fq == 0) SSQ[row * 16 + u.pn * 4 + wc] = ss; }
            asm volatile("" ::: "memory"); }
    }
};
template <int ACT> struct EpiScaleBf16 {
    static constexpr bool PERM = true, AFTER_DRAIN = false;
    bf16* O; int ldo; LAS unsigned char* lds;
    __device__ __forceinline__ void operator()(const f32x4 (&acc)[2][2][4][2], const Unit& u, int wr, int wc, int fr, int fq) const {
        const int colb = u.pn * 256 + wc * 32 + 8 * fq; const LAS float* rt = rstd_table_rows(lds, u.pm);
#pragma unroll
        for (int ai = 0; ai < 2; ++ai)
#pragma unroll
            for (int m = 0; m < 4; ++m) { const int rl = ai * 128 + wr * 64 + m * 16 + fr, row = u.pm * 256 + rl; const float rs = rt[rl];
#pragma unroll
                for (int bj = 0; bj < 2; ++bj) { f32x4 v0 = acc[ai][bj][m][0] * rs, v1 = acc[ai][bj][m][1] * rs;
                    if (ACT == 1) {
#pragma unroll
                        for (int e = 0; e < 4; ++e) { const float a = fmaxf(v0[e], 0.f), b = fmaxf(v1[e], 0.f); v0[e] = a * a; v1[e] = b * b; } }
                    *(v4u*)(O + (size_t)row * ldo + colb + bj * 128) = pack8(v0, v1); }
                __builtin_amdgcn_sched_barrier(0); }
    }
};
}
namespace fk {
typedef float f32x4m __attribute__((ext_vector_type(4)));
#define MFMA16(a, b, c) __builtin_amdgcn_mfma_f32_16x16x32_bf16((a), (b), (c), 0, 0, 0)
constexpr int IMG_LD = 136;
constexpr int IMG128 = 128 * IMG_LD * 2;
constexpr int IMG144 = 144 * IMG_LD * 2;
__device__ __forceinline__ bf16x8 lds_frag(LAS unsigned char* lds, int img, int row, int k) { return *(const LAS bf16x8*)(lds + img + row * (IMG_LD * 2) + k * 2); }
__device__ __forceinline__ v2u pack4(float a, float b, float c, float d) { v2u w; w.x = cvtpk(a, b); w.y = cvtpk(c, d); return w; }
__device__ __forceinline__ float sigmoid_f(float x) { return __builtin_amdgcn_rcpf(1.f + __expf(-x)); }
#ifdef FK_STAMPS
#define USTAMP(k) do { if (l == 0 && b == 0 && h == 0 && jj == 0 && wave == 0 && lane == 0) ((unsigned long long*)(ws + WS_CTL + 32768 * 4))[k] = __builtin_amdgcn_s_memrealtime(); } while (0)
#else
#define USTAMP(k) do { } while (0)
#endif
__device__ __forceinline__ int opaque(int x) { asm volatile("" : "+v"(x)); return x; }

__device__ __forceinline__ void gate_prelude_mfma(unsigned char* ws, LAS unsigned char* lds, int l, int gw_, int wave) {
    const int lane = lane_id_asm(), tid = wave * 64 + lane, fr = lane & 15, g = lane >> 4; int gw = gw_; asm volatile("" : "+s"(gw));
    constexpr int WLD = 1032;
    const bf16* WGB = (const bf16*)(ws + WS_WG + 65536) + l * 16384; const bf16* XB = (const bf16*)(ws + WS_XB); const float* SSQ = (const float*)(ws + WS_SSQ); float* GATES = (float*)(ws + WS_GATES);
    v4u wreg[4];
#pragma unroll
    for (int it = 0; it < 4; ++it) { const int ch = tid + it * NTHR; wreg[it] = *(const v4u*)(WGB + (size_t)ch * 8); }
    const bool active = gw < MT / 16; const int r0 = active ? 16 * gw : 0;
    bf16x8 af[32];
#pragma unroll
    for (int st = 0; st < 32; ++st) af[st] = *(const bf16x8*)(XB + (size_t)(r0 + fr) * D + 32 * st + 8 * g);
    asm volatile("" ::: "memory");
    LBAR();
#pragma unroll
    for (int it = 0; it < 4; ++it) { const int ch = tid + it * NTHR, row = ch >> 7, c16 = ch & 127; *(LAS v4u*)(lds + row * (WLD * 2) + c16 * 16) = wreg[it]; }
    LBAR();
    float ssq = 0.f;
#pragma unroll
    for (int st = 0; st < 32; ++st) { const v4u w = __builtin_bit_cast(v4u, af[st]);
#pragma unroll
        for (int e = 0; e < 4; ++e) { const float lo = __builtin_bit_cast(float, w[e] << 16), hi = __builtin_bit_cast(float, w[e] & 0xffff0000u); ssq += lo * lo + hi * hi; } }
    ssq += __shfl_xor(ssq, 16); ssq += __shfl_xor(ssq, 32);
    const float rsrow = rsqrtf(ssq * (1.f / 1024.f) + EPS);
    f32x4 acc = (f32x4){0.f, 0.f, 0.f, 0.f};
#pragma unroll
    for (int st = 0; st < 32; ++st) acc = MFMA16(af[st], *(const LAS bf16x8*)(lds + fr * (WLD * 2) + (32 * st + 8 * g) * 2), acc);
#pragma unroll
    for (int r = 0; r < 4; ++r) { const float rs = __shfl(rsrow, 4 * g + r);
        if (active && fr < 8) GATES[(size_t)(r0 + 4 * g + r) * 8 + fr] = acc[r] * rs; }
    LBAR();
}

__device__ __forceinline__ void mlstm_local_unit(const float* const* in, unsigned char* ws, LAS unsigned char* lds, int l, int b, int h, int jj, int wave) {
    const int lane = lane_id_asm(), tid = wave * 64 + lane;
    constexpr int O_WK = 0, O_WV = IMG128, O_KT = 2 * IMG128, O_VT = 3 * IMG128, O_SC = 3 * IMG128 + IMG144;
    LAS float* sS = (LAS float*)(lds + O_SC); LAS float* sG = sS + 128; LAS float* sR = sG + 128;
    const int r0 = b * SEQ + 128 * jj, unit = (b * 4 + h) * 16 + jj;
    const float* GATES = (const float*)(ws + WS_GATES); float* BT = (float*)(ws + WS_BT); float* UNITS = (float*)(ws + WS_UNITS);
    const size_t bo = (size_t)b * TMP_BSTRIDE;
    const bf16* XM = (const bf16*)(ws + WS_XM) + bo; bf16* CONV = (bf16*)(ws + WS_CONV) + bo; bf16* Q = (bf16*)(ws + WS_Q) + bo; bf16* KP = (bf16*)(ws + WS_KP) + bo; bf16* VT = (bf16*)(ws + WS_VT) + bo;
    const bf16* HW = (const bf16*)(ws + WS_HW) + (size_t)l * 3 * 4 * 16384;
    const bf16* wqT = HW + (size_t)(0 * 4 + h) * 16384; const bf16* wkT = HW + (size_t)(1 * 4 + h) * 16384; const bf16* wvT = HW + (size_t)(2 * 4 + h) * 16384;
    USTAMP(50);
    const int fr = lane & 15, g = lane >> 4, t = 16 * wave + fr, pos = 128 * jj + t;
    float gi = 0.f, gf = 0.f;
    if (tid < 128) { gi = GATES[(size_t)(r0 + tid) * 8 + h]; gf = GATES[(size_t)(r0 + tid) * 8 + 4 + h]; }
    v4u xall[4][4];
#pragma unroll
    for (int st = 0; st < 4; ++st)
#pragma unroll
        for (int i = 0; i < 4; ++i) { const int dr = (pos - 3 + i >= 0) ? (t - 3 + i) : t;
            xall[st][i] = *(const v4u*)(XM + (size_t)(r0 + dr) * 512 + h * 128 + 32 * st + 8 * g); }
#pragma unroll
    for (int st = 0; st < 4; ++st)
#pragma unroll
        for (int i = 0; i < 3; ++i) if (pos - 3 + i < 0) xall[st][i] = (v4u){0u, 0u, 0u, 0u};
    v4u sreg[8];
#pragma unroll
    for (int it = 0; it < 8; ++it) { const int ch = tid + it * NTHR, which = ch >> 11, rem = ch & 2047, row = rem >> 4, c16 = rem & 15; sreg[it] = *(const v4u*)((which ? wvT : wkT) + row * 128 + c16 * 8); }
    f32x4 cwv = (f32x4){0.f, 0.f, 0.f, 0.f};
    if (tid < 160) { const int rw = tid >> 5, c4 = (tid & 31) * 4; cwv = rw < 4 ? *(const f32x4*)(in[14] + (size_t)l * 2048 + rw * 512 + h * 128 + c4) : *(const f32x4*)(in[15] + (size_t)l * 512 + h * 128 + c4); }
    LAS float* sCW = sR + 8;
    LBAR();
    USTAMP(51);
#pragma unroll
    for (int it = 0; it < 8; ++it) { const int ch = tid + it * NTHR, which = ch >> 11, rem = ch & 2047, row = rem >> 4, c16 = rem & 15;
        *(LAS v4u*)(lds + (which ? O_WV : O_WK) + row * (IMG_LD * 2) + c16 * 16) = sreg[it]; }
    if (tid < 160) *(LAS f32x4*)(sCW + 4 * tid) = cwv;
    for (int i = tid; i < 16 * IMG_LD / 2; i += NTHR) { const int row = i / (IMG_LD / 2); ((LAS unsigned*)(lds + O_VT + 128 * IMG_LD * 2))[i] = row == 0 ? 0x3f803f80u : 0u; }
    USTAMP(52);
    float ig = 0.f, bt = 0.f;
    if (tid < 128) { ig = gi + in[19][l * 4 + h]; const float z = gf + in[20][l * 4 + h];
        bt = fminf(z, 0.f) - __logf(1.f + __expf(-fabsf(z)));
#pragma unroll
        for (int o = 1; o < 64; o <<= 1) { const float up = __shfl_up(bt, o); if (lane >= o) bt += up; }
        if (tid == 63) sS[0] = bt; }
    LBAR();
    if (tid >= 64 && tid < 128) bt += sS[0];
    float gt = ig - bt;
    if (tid < 128) { float mx = gt;
#pragma unroll
        for (int o = 32; o > 0; o >>= 1) mx = fmaxf(mx, __shfl_xor(mx, o));
        if (lane == 0) sR[wave] = mx; }
    LBAR();
    USTAMP(53);
    const float cmax = fmaxf(sR[0], sR[1]);
    if (tid < 128) { sG[tid] = __expf(gt - cmax); BT[(size_t)(r0 + tid) * 4 + h] = bt; if (tid == 127) { UNITS[unit * 4 + 0] = cmax; UNITS[unit * 4 + 1] = bt; } }
    bf16x8 CA[4], XF[4];
#pragma unroll
    for (int st = 0; st < 4; ++st) { const int c0 = 32 * st + 8 * g;
        float a[8];
        { const f32x4 b0 = *(const LAS f32x4*)(sCW + 512 + c0), b1 = *(const LAS f32x4*)(sCW + 512 + c0 + 4);
#pragma unroll
          for (int e = 0; e < 4; ++e) { a[e] = b0[e]; a[4 + e] = b1[e]; } }
#pragma unroll
        for (int i = 0; i < 4; ++i) { const v4u xv = xall[st][i];
            const f32x4 w0 = *(const LAS f32x4*)(sCW + i * 128 + c0), w1 = *(const LAS f32x4*)(sCW + i * 128 + c0 + 4);
#pragma unroll
            for (int e = 0; e < 4; ++e) { const float lo = __builtin_bit_cast(float, xv[e] << 16), hi = __builtin_bit_cast(float, xv[e] & 0xffff0000u);
                a[2 * e] += lo * (e < 2 ? w0[2 * e] : w1[2 * e - 4]); a[2 * e + 1] += hi * (e < 2 ? w0[2 * e + 1] : w1[2 * e - 3]); }
            if (i == 3) XF[st] = __builtin_bit_cast(bf16x8, xv); }
#pragma unroll
        for (int e = 0; e < 8; ++e) a[e] = a[e] * sigmoid_f(a[e]);
        const v4u cv = (v4u){cvtpk(a[0], a[1]), cvtpk(a[2], a[3]), cvtpk(a[4], a[5]), cvtpk(a[6], a[7])};
        CA[st] = __builtin_bit_cast(bf16x8, cv);
        *(v4u*)(CONV + (size_t)(r0 + t) * 512 + h * 128 + c0) = cv; }
    bf16x8 wqf[8][4];
#pragma unroll
    for (int it = 0; it < 8; ++it)
#pragma unroll
        for (int st = 0; st < 4; ++st) wqf[it][st] = *(const bf16x8*)(wqT + (16 * it + fr) * 128 + 32 * st + 8 * g);
    USTAMP(54);
    LBAR();
    USTAMP(55);
    const float sgY = sG[t];
    f32x4 sgX; sgX[0] = sG[16 * wave + 4 * g]; sgX[1] = sG[16 * wave + 4 * g + 1]; sgX[2] = sG[16 * wave + 4 * g + 2]; sgX[3] = sG[16 * wave + 4 * g + 3];
#pragma unroll
    for (int it = 0; it < 8; ++it) {
        f32x4 ak = (f32x4){0.f, 0.f, 0.f, 0.f}, akx = ak, avx = ak;
#pragma unroll
        for (int st = 0; st < 4; ++st) {
            const bf16x8 wk = lds_frag(lds, O_WK, 16 * it + fr, 32 * st + 8 * g), wv = lds_frag(lds, O_WV, 16 * it + fr, 32 * st + 8 * g);
            ak = MFMA16(wk, CA[st], ak); akx = MFMA16(CA[st], wk, akx); avx = MFMA16(XF[st], wv, avx);
        }
        *(v2u*)(KP + (size_t)(r0 + t) * 512 + h * 128 + 16 * it + 4 * g) = pack4(ak[0] * sgY, ak[1] * sgY, ak[2] * sgY, ak[3] * sgY);
        *(LAS v2u*)(lds + O_KT + (16 * it + fr) * (IMG_LD * 2) + (16 * wave + 4 * g) * 2) = pack4(akx[0] * sgX[0], akx[1] * sgX[1], akx[2] * sgX[2], akx[3] * sgX[3]);
        const v2u vv = pack4(avx[0], avx[1], avx[2], avx[3]);
        *(LAS v2u*)(lds + O_VT + (16 * it + fr) * (IMG_LD * 2) + (16 * wave + 4 * g) * 2) = vv;
        *(v2u*)(VT + ((size_t)(b * 4 + h) * 128 + 16 * it + fr) * SEQ + 128 * jj + 16 * wave + 4 * g) = vv;
        __builtin_amdgcn_sched_barrier(0);
    }
    USTAMP(56);
    LBAR();
    USTAMP(57);
    bf16* UE = (bf16*)(ws + WS_UEXT) + (size_t)unit * 144 * 128;
    bf16x8 kf[4];
#pragma unroll
    for (int st = 0; st < 4; ++st) kf[st] = lds_frag(lds, O_KT, 16 * wave + fr, 32 * st + 8 * g);
#pragma unroll 3
    for (int dt = 0; dt < 9; ++dt) { f32x4 au = (f32x4){0.f, 0.f, 0.f, 0.f};
#pragma unroll
        for (int st = 0; st < 4; ++st) au = MFMA16(kf[st], lds_frag(lds, O_VT, 16 * dt + fr, 32 * st + 8 * g), au);
        *(v2u*)(UE + (size_t)(16 * dt + fr) * 128 + 16 * wave + 4 * g) = pack4(au[0], au[1], au[2], au[3]); }
    __builtin_amdgcn_sched_barrier(0);
#pragma unroll
    for (int it = 0; it < 8; ++it) { f32x4 aq = (f32x4){0.f, 0.f, 0.f, 0.f};
#pragma unroll
        for (int st = 0; st < 4; ++st) aq = MFMA16(wqf[it][st], CA[st], aq);
        *(v2u*)(Q + (size_t)(r0 + t) * 512 + h * 128 + 16 * it + 4 * g) = pack4(aq[0], aq[1], aq[2], aq[3]); }
    USTAMP(58);
}

__device__ __forceinline__ void gmlp_unit(const float* const* in, unsigned char* ws, LAS unsigned char* lds, int l, int b, int n, int h, int wave) {
    const int lane = lane_id_asm(), tid = wave * 64 + lane;
    constexpr int O_WS = 0, O_VG = IMG128, O_RS = 2 * IMG128;
    LAS float* sRS = (LAS float*)(lds + O_RS);
    const int r0 = b * SEQ + 128 * n;
    const bf16* VG = (const bf16*)(ws + WS_VG); const bf16* U = (const bf16*)(ws + WS_U); bf16* YMIX = (bf16*)(ws + WS_YMIX); const float* SSQV = (const float*)(ws + WS_SSQV);
    const float* wsp = in[12] + (size_t)l * 65536 + (size_t)h * 16384; const float* bsp = in[13] + (size_t)l * 512 + h * 128; const float* gvg = in[11] + (size_t)l * 512 + h * 128;
    f32x4 sa = (f32x4){0.f, 0.f, 0.f, 0.f}, sb = sa;
    if (tid < 128) { sa = *(const f32x4*)(SSQV + (size_t)(r0 + tid) * 8); sb = *(const f32x4*)(SSQV + (size_t)(r0 + tid) * 8 + 4); }
    f32x4 wreg[8]; v4u vreg[4];
#pragma unroll
    for (int it = 0; it < 8; ++it) { const int ch = tid + it * NTHR, tt = ch >> 5, s0 = (ch & 31) * 4; wreg[it] = *(const f32x4*)(wsp + tt * 128 + s0); }
#pragma unroll
    for (int it = 0; it < 4; ++it) { const int ch = tid + it * NTHR, sidx = ch & 127, d0 = (ch >> 7) * 8; vreg[it] = *(const v4u*)(VG + (size_t)b * TMP_BSTRIDE + (size_t)(r0 + sidx) * 512 + h * 128 + d0); }
    const int fr = lane & 15, g = lane >> 4, t = 16 * wave + fr, nst = (16 * wave + 15) / 32 + 1;
    v2u uur[8]; f32x4 gvr[8];
#pragma unroll
    for (int dt = 0; dt < 8; ++dt) { uur[dt] = *(const v2u*)(U + (size_t)b * TMP_BSTRIDE + (size_t)(r0 + t) * 512 + h * 128 + 16 * dt + 4 * g); gvr[dt] = *(const f32x4*)(gvg + 16 * dt + 4 * g); }
    const float bsv = bsp[t];
    asm volatile("" ::: "memory");
    LBAR();
    if (tid < 128) sRS[tid] = rsqrtf((((sa[0] + sa[1]) + (sa[2] + sa[3])) + ((sb[0] + sb[1]) + (sb[2] + sb[3]))) * (1.f / 512.f) + EPS);
#pragma unroll
    for (int it = 0; it < 4; ++it) { const int ch = tid + it * NTHR, sidx = ch & 127, d0 = (ch >> 7) * 8; const v4u v = vreg[it];
#pragma unroll
        for (int e = 0; e < 4; ++e) { *(LAS unsigned short*)(lds + O_VG + (d0 + 2 * e) * (IMG_LD * 2) + sidx * 2) = (unsigned short)(v[e] & 0xffffu);
                                       *(LAS unsigned short*)(lds + O_VG + (d0 + 2 * e + 1) * (IMG_LD * 2) + sidx * 2) = (unsigned short)(v[e] >> 16); } }
    LBAR();
#pragma unroll
    for (int it = 0; it < 8; ++it) { const int ch = tid + it * NTHR, tt = ch >> 5, s0 = (ch & 31) * 4; const f32x4 w = wreg[it];
        float v[4];
#pragma unroll
        for (int e = 0; e < 4; ++e) v[e] = (s0 + e <= tt) ? w[e] * sRS[s0 + e] : 0.f;
        *(LAS v2u*)(lds + O_WS + tt * (IMG_LD * 2) + s0 * 2) = pack4(v[0], v[1], v[2], v[3]); }
    LBAR();
    bf16x8 wf[4];
#pragma unroll
    for (int st = 0; st < 4; ++st) wf[st] = lds_frag(lds, O_WS, t, 32 * st + 8 * g);
#pragma unroll
    for (int dt = 0; dt < 8; ++dt) { f32x4 am = (f32x4){0.f, 0.f, 0.f, 0.f};
#pragma unroll
        for (int st = 0; st < 4; ++st) if (st < nst) am = MFMA16(lds_frag(lds, O_VG, 16 * dt + fr, 32 * st + 8 * g), wf[st], am);
        const int d0 = 16 * dt + 4 * g; const f32x4 gv = gvr[dt]; const v2u uu = uur[dt];
        const float u0 = __builtin_bit_cast(float, uu[0] << 16), u1 = __builtin_bit_cast(float, uu[0] & 0xffff0000u), u2 = __builtin_bit_cast(float, uu[1] << 16), u3 = __builtin_bit_cast(float, uu[1] & 0xffff0000u);
        *(v2u*)(YMIX + (size_t)(r0 + t) * 1024 + h * 128 + d0) = pack4(u0 * (am[0] * gv[0] + bsv), u1 * (am[1] * gv[1] + bsv), u2 * (am[2] * gv[2] + bsv), u3 * (am[3] * gv[3] + bsv)); }
}

__device__ __forceinline__ void gmlp_pair(const float* const* in, unsigned char* ws, LAS unsigned char* lds, int l, int bA, int bB, int nA, int nB, int h, int wave) {
    const int lane = lane_id_asm(), tid = wave * 64 + lane;
    constexpr int LQ = 2 * IMG128 + 1024;
    constexpr int O_WS = 0, O_VG = IMG128, O_RS = 2 * IMG128;
    const bf16* VG = (const bf16*)(ws + WS_VG); const bf16* U = (const bf16*)(ws + WS_U); bf16* YMIX = (bf16*)(ws + WS_YMIX); const float* SSQV = (const float*)(ws + WS_SSQV);
    const float* wsp = in[12] + (size_t)l * 65536 + (size_t)h * 16384; const float* bsp = in[13] + (size_t)l * 512 + h * 128; const float* gvg = in[11] + (size_t)l * 512 + h * 128;
    const int fr = lane & 15, g = lane >> 4, t = 16 * wave + fr, nst = (16 * wave + 15) / 32 + 1;
    int r0[2]; r0[0] = bA * SEQ + 128 * nA; r0[1] = bB * SEQ + 128 * nB;
    f32x4 sa[2], sb[2]; v4u vreg[2][4]; v2u uur[2][8];
#pragma unroll
    for (int q = 0; q < 2; ++q) { sa[q] = (f32x4){0.f, 0.f, 0.f, 0.f}; sb[q] = sa[q];
        if (tid < 128) { sa[q] = *(const f32x4*)(SSQV + (size_t)(r0[q] + tid) * 8); sb[q] = *(const f32x4*)(SSQV + (size_t)(r0[q] + tid) * 8 + 4); }
#pragma unroll
        for (int it = 0; it < 4; ++it) { const int ch = tid + it * NTHR, sidx = ch & 127, d0 = (ch >> 7) * 8; vreg[q][it] = *(const v4u*)(VG + (size_t)(q ? bB : bA) * TMP_BSTRIDE + (size_t)(r0[q] + sidx) * 512 + h * 128 + d0); }
#pragma unroll
        for (int dt = 0; dt < 8; ++dt) uur[q][dt] = *(const v2u*)(U + (size_t)(q ? bB : bA) * TMP_BSTRIDE + (size_t)(r0[q] + t) * 512 + h * 128 + 16 * dt + 4 * g); }
    f32x4 wreg[8], gvr[8];
#pragma unroll
    for (int it = 0; it < 8; ++it) { const int ch = tid + it * NTHR, tt = ch >> 5, s0 = (ch & 31) * 4; wreg[it] = *(const f32x4*)(wsp + tt * 128 + s0); }
#pragma unroll
    for (int dt = 0; dt < 8; ++dt) gvr[dt] = *(const f32x4*)(gvg + 16 * dt + 4 * g);
    const float bsv = bsp[t];
    asm volatile("" ::: "memory");
    LBAR();
#pragma unroll
    for (int q = 0; q < 2; ++q) { LAS unsigned char* lq = lds + q * LQ; LAS float* sRS = (LAS float*)(lq + O_RS);
        if (tid < 128) sRS[tid] = rsqrtf((((sa[q][0] + sa[q][1]) + (sa[q][2] + sa[q][3])) + ((sb[q][0] + sb[q][1]) + (sb[q][2] + sb[q][3]))) * (1.f / 512.f) + EPS);
#pragma unroll
        for (int it = 0; it < 4; ++it) { const int ch = tid + it * NTHR, sidx = ch & 127, d0 = (ch >> 7) * 8; const v4u v = vreg[q][it];
#pragma unroll
            for (int e = 0; e < 4; ++e) { *(LAS unsigned short*)(lq + O_VG + (d0 + 2 * e) * (IMG_LD * 2) + sidx * 2) = (unsigned short)(v[e] & 0xffffu);
                                           *(LAS unsigned short*)(lq + O_VG + (d0 + 2 * e + 1) * (IMG_LD * 2) + sidx * 2) = (unsigned short)(v[e] >> 16); } } }
    LBAR();
#pragma unroll
    for (int q = 0; q < 2; ++q) { LAS unsigned char* lq = lds + q * LQ; const LAS float* sRS = (const LAS float*)(lq + O_RS);
#pragma unroll
        for (int it = 0; it < 8; ++it) { const int ch = tid + it * NTHR, tt = ch >> 5, s0 = (ch & 31) * 4; const f32x4 w = wreg[it];
            float v[4];
#pragma unroll
            for (int e = 0; e < 4; ++e) v[e] = (s0 + e <= tt) ? w[e] * sRS[s0 + e] : 0.f;
            *(LAS v2u*)(lq + O_WS + tt * (IMG_LD * 2) + s0 * 2) = pack4(v[0], v[1], v[2], v[3]); } }
    LBAR();
#pragma unroll
    for (int q = 0; q < 2; ++q) { LAS unsigned char* lq = lds + q * LQ;
        bf16x8 wf[4];
#pragma unroll
        for (int st = 0; st < 4; ++st) wf[st] = lds_frag(lq, O_WS, t, 32 * st + 8 * g);
#pragma unroll
        for (int dt = 0; dt < 8; ++dt) { f32x4 am = (f32x4){0.f, 0.f, 0.f, 0.f};
#pragma unroll
            for (int st = 0; st < 4; ++st) if (st < nst) am = MFMA16(lds_frag(lq, O_VG, 16 * dt + fr, 32 * st + 8 * g), wf[st], am);
            const int d0 = 16 * dt + 4 * g; const f32x4 gv = gvr[dt]; const v2u uu = uur[q][dt];
            const float u0 = __builtin_bit_cast(float, uu[0] << 16), u1 = __builtin_bit_cast(float, uu[0] & 0xffff0000u), u2 = __builtin_bit_cast(float, uu[1] << 16), u3 = __builtin_bit_cast(float, uu[1] & 0xffff0000u);
            *(v2u*)(YMIX + (size_t)(r0[q] + t) * 1024 + h * 128 + d0) = pack4(u0 * (am[0] * gv[0] + bsv), u1 * (am[1] * gv[1] + bsv), u2 * (am[2] * gv[2] + bsv), u3 * (am[3] * gv[3] + bsv)); }
        __builtin_amdgcn_sched_barrier(0); }
}

__device__ __forceinline__ void mlstm_out_unit(const float* const* in, unsigned char* ws, float* out, LAS unsigned char* lds, int l, int b, int h, int jj, int wave) {
    const int lane = lane_id_asm(), tid = wave * 64 + lane;
    constexpr int O_K = 0, O_V = IMG128, O_C = IMG128 + IMG144, O_P = IMG128 + 2 * IMG144, PW = 16 * IMG_LD * 2;
    const int r0 = b * SEQ + 128 * jj, ubase = (b * 4 + h) * 16;
    const float* UNITS = (const float*)(ws + WS_UNITS); const float* BT = (const float*)(ws + WS_BT);
    const size_t bo = (size_t)b * TMP_BSTRIDE;
    const bf16* Q = (const bf16*)(ws + WS_Q) + bo; const bf16* KP = (const bf16*)(ws + WS_KP) + bo; const bf16* VT = (const bf16*)(ws + WS_VT) + bo; const bf16* CONV = (const bf16*)(ws + WS_CONV) + bo; const bf16* OP = (const bf16*)(ws + WS_OP) + bo;
    bf16* YMIX = (bf16*)(ws + WS_YMIX); const float* UEX = (const float*)(ws + WS_UEXT) + (size_t)ubase * 144 * 128;
    USTAMP(80);
    const float cj = UNITS[(ubase + jj) * 4 + 0];
    const float sC = __expf(UNITS[(ubase + jj) * 4 + 2] - cj);
    const int fr = lane & 15, g = lane >> 4, t = 16 * wave + fr;
    v4u creg[5], kreg[4], vreg[4];
    { const bf16* CP = (const bf16*)(ws + WS_CPRE) + (size_t)(ubase + jj) * 18432;
#pragma unroll
      for (int it = 0; it < 5; ++it) { int ch = tid + it * NTHR; ch = ch < 2304 ? ch : 2303; creg[it] = *(const v4u*)(CP + (size_t)ch * 8); } }
#pragma unroll
    for (int it = 0; it < 4; ++it) { const int ch = tid + it * NTHR, row = ch >> 4, c16 = ch & 15;
        kreg[it] = *(const v4u*)(KP + (size_t)(r0 + row) * 512 + h * 128 + c16 * 8);
        vreg[it] = *(const v4u*)(VT + ((size_t)(b * 4 + h) * 128 + row) * SEQ + 128 * jj + c16 * 8); }
    bf16x8 qf[4];
#pragma unroll
    for (int st = 0; st < 4; ++st) qf[st] = *(const bf16x8*)(Q + (size_t)(r0 + t) * 512 + h * 128 + 32 * st + 8 * g);
    const float btv = BT[(size_t)(r0 + t) * 4 + h];
    v2u ovr[8], cvr[8];
#pragma unroll
    for (int dt = 0; dt < 8; ++dt) { ovr[dt] = *(const v2u*)(OP + (size_t)(r0 + t) * 512 + h * 128 + 16 * dt + 4 * g); cvr[dt] = *(const v2u*)(CONV + (size_t)(r0 + t) * 512 + h * 128 + 16 * dt + 4 * g); }
    const float* og = in[21] + (size_t)l * 512 + h * 128; const float* sk = in[22] + (size_t)l * 512 + h * 128;
    f32x4 ogr[8], skr[8];
#pragma unroll
    for (int dt = 0; dt < 8; ++dt) { ogr[dt] = *(const f32x4*)(og + 16 * dt + 4 * g); skr[dt] = *(const f32x4*)(sk + 16 * dt + 4 * g); }
    asm volatile("" ::: "memory");
    LBAR();
#pragma unroll
    for (int it = 0; it < 5; ++it) { int ch = tid + it * NTHR; ch = ch < 2304 ? ch : 2303;
        const int e = ch * 8, ic = e / 2304, rem = e - ic * 2304, d = rem >> 4, i = 16 * ic + (rem & 15);
        *(LAS v4u*)(lds + O_C + d * (IMG_LD * 2) + i * 2) = creg[it]; }
#pragma unroll
    for (int it = 0; it < 4; ++it) { const int ch = tid + it * NTHR, row = ch >> 4, c16 = ch & 15;
        *(LAS v4u*)(lds + O_K + row * (IMG_LD * 2) + c16 * 16) = kreg[it]; *(LAS v4u*)(lds + O_V + row * (IMG_LD * 2) + c16 * 16) = vreg[it]; }
    for (int i = tid; i < 16 * IMG_LD / 2; i += NTHR) { const int row = i / (IMG_LD / 2); ((LAS unsigned*)(lds + O_V + 128 * IMG_LD * 2))[i] = row == 0 ? 0x3f803f80u : 0u; }
    USTAMP(81);
    LBAR();
    USTAMP(82);
    const int pw = O_P + wave * PW;
    for (int n = 0; n <= wave; ++n) { f32x4 as = (f32x4){0.f, 0.f, 0.f, 0.f};
#pragma unroll
        for (int st = 0; st < 4; ++st) as = MFMA16(lds_frag(lds, O_K, 16 * n + fr, 32 * st + 8 * g), qf[st], as);
        if (n == wave) {
#pragma unroll
            for (int r = 0; r < 4; ++r) if (4 * g + r > fr) as[r] = 0.f; }
        *(LAS v2u*)(lds + pw + fr * (IMG_LD * 2) + (16 * n + 4 * g) * 2) = pack4(as[0], as[1], as[2], as[3]); }
    if ((wave & 1) == 0) { unsigned z; asm volatile("v_mov_b32 %0, 0" : "=v"(z));
        *(LAS v2u*)(lds + pw + fr * (IMG_LD * 2) + (16 * (wave + 1) + 4 * g) * 2) = (v2u){z, z}; }
    LDS_WAIT(); asm volatile("" ::: "memory");
    USTAMP(83);
    const int nst = (wave >> 1) + 1;
    bf16x8 pf[4];
#pragma unroll
    for (int st = 0; st < 4; ++st) pf[st] = (st < nst) ? lds_frag(lds, pw, fr, 32 * st + 8 * g) : qf[0];
    f32x4 hv[9];
#pragma unroll
    for (int dt = 0; dt < 9; ++dt) { f32x4 a2 = (f32x4){0.f, 0.f, 0.f, 0.f}, a3 = a2;
#pragma unroll
        for (int st = 0; st < 4; ++st) if (st < nst) a2 = MFMA16(lds_frag(lds, O_V, 16 * dt + fr, 32 * st + 8 * g), pf[st], a2);
#pragma unroll
        for (int st = 0; st < 4; ++st) a3 = MFMA16(lds_frag(lds, O_C, 16 * dt + fr, 32 * st + 8 * g), qf[st], a3);
        hv[dt] = a2 + a3 * sC; __builtin_amdgcn_sched_barrier(0); }
    USTAMP(84);
    const float den = __shfl(hv[8][0], fr);
    const float inv = __builtin_amdgcn_rcpf(fmaxf(fabsf(den), __expf(-(btv + cj))));
    float ss = 0.f;
#pragma unroll
    for (int dt = 0; dt < 8; ++dt) { hv[dt] = hv[dt] * inv; ss += (hv[dt][0] * hv[dt][0] + hv[dt][1] * hv[dt][1]) + (hv[dt][2] * hv[dt][2] + hv[dt][3] * hv[dt][3]); }
    ss += __shfl_xor(ss, 16); ss += __shfl_xor(ss, 32);
    const float rs = rsqrtf(ss * (1.f / 128.f) + EPS);
#pragma unroll
    for (int dt = 0; dt < 8; ++dt) { const int d0 = 16 * dt + 4 * g; const f32x4 ogv = ogr[dt], skv = skr[dt];
        const v2u ov = ovr[dt], cv = cvr[dt];
        float o[4], c[4];
        o[0] = __builtin_bit_cast(float, ov[0] << 16); o[1] = __builtin_bit_cast(float, ov[0] & 0xffff0000u); o[2] = __builtin_bit_cast(float, ov[1] << 16); o[3] = __builtin_bit_cast(float, ov[1] & 0xffff0000u);
        c[0] = __builtin_bit_cast(float, cv[0] << 16); c[1] = __builtin_bit_cast(float, cv[0] & 0xffff0000u); c[2] = __builtin_bit_cast(float, cv[1] << 16); c[3] = __builtin_bit_cast(float, cv[1] & 0xffff0000u);
        float y[4];
#pragma unroll
        for (int e = 0; e < 4; ++e) y[e] = sigmoid_f(o[e]) * (hv[dt][e] * rs * ogv[e] + skv[e] * c[e]);
        *(v2u*)(YMIX + (size_t)(r0 + t) * 1024 + 512 + h * 128 + d0) = pack4(y[0], y[1], y[2], y[3]); __builtin_amdgcn_sched_barrier(0); }
    USTAMP(85);
}
__device__ __forceinline__ void mlstm_scan_unit(unsigned char* ws, float* out, LAS unsigned char* lds, int l, int b, int h, int ic, int wave) {
    const int lane = lane_id_asm(), tid = wave * 64 + lane, ubase = (b * 4 + h) * 16;
    float* UNITS = (float*)(ws + WS_UNITS); const bf16* UEX = (const bf16*)(ws + WS_UEXT) + (size_t)ubase * 18432 + 16 * ic;
    bf16* CPRE = (bf16*)(ws + WS_CPRE) + (size_t)ubase * 18432 + ic * 2304;
    const bool two = tid < 64;
    const int off0 = (tid >> 2) * 128 + (tid & 3) * 4, off1 = two ? ((512 + tid) >> 2) * 128 + (tid & 3) * 4 : off0;
    float m = 0.f; f32x4 s0 = (f32x4){0.f, 0.f, 0.f, 0.f}, s1 = s0;
    __syncthreads();
#pragma unroll 1
    for (int xb = 0; xb < 16; xb += 8) {
        f32x4 u0[8], u1[8]; float cx[8], bl[8];
#pragma unroll
        for (int x = 0; x < 8; ++x) { const v2u p0 = *(const v2u*)(UEX + (size_t)(xb + x) * 18432 + off0), p1 = *(const v2u*)(UEX + (size_t)(xb + x) * 18432 + off1);
            u0[x] = (f32x4){__builtin_bit_cast(float, p0[0] << 16), __builtin_bit_cast(float, p0[0] & 0xffff0000u), __builtin_bit_cast(float, p0[1] << 16), __builtin_bit_cast(float, p0[1] & 0xffff0000u)};
            u1[x] = (f32x4){__builtin_bit_cast(float, p1[0] << 16), __builtin_bit_cast(float, p1[0] & 0xffff0000u), __builtin_bit_cast(float, p1[1] << 16), __builtin_bit_cast(float, p1[1] & 0xffff0000u)};
            cx[x] = UNITS[(ubase + xb + x) * 4 + 0]; bl[x] = UNITS[(ubase + xb + x) * 4 + 1]; }
        asm volatile("" ::: "memory");
#pragma unroll
        for (int x = 0; x < 8; ++x) {
            *(v2u*)(CPRE + (size_t)(xb + x) * 18432 + 4 * tid) = pack4(s0[0], s0[1], s0[2], s0[3]);
            if (two) *(v2u*)(CPRE + (size_t)(xb + x) * 18432 + 2048 + 4 * tid) = pack4(s1[0], s1[1], s1[2], s1[3]);
            if (ic == 0 && tid == 0) UNITS[(ubase + xb + x) * 4 + 2] = m;
            const float mn = fmaxf(bl[x] + m, bl[x] + cx[x]), fa = __expf(bl[x] + m - mn), fb = __expf(bl[x] + cx[x] - mn);
            s0 = s0 * fa + u0[x] * fb; s1 = s1 * fa + u1[x] * fb; m = mn; }
    }
    LAS float* T = (LAS float*)lds;
    { const int d = tid >> 2, i4 = (tid & 3) * 4;
#pragma unroll
      for (int k = 0; k < 4; ++k) T[(i4 + k) * 148 + d] = s0[k];
      if (two) { const int d1 = (512 + tid) >> 2;
#pragma unroll
          for (int k = 0; k < 4; ++k) T[(i4 + k) * 148 + d1] = s1[k]; } }
    __syncthreads();
    float* Cp = out + O_CP + (size_t)l * 524288 + (size_t)(b * 4 + h) * 16384 + (size_t)(16 * ic) * 128; float* Np = out + O_NP + (size_t)l * 4096 + (b * 4 + h) * 128 + 16 * ic;
    { const int i = tid >> 5, d4 = (tid & 31) * 4; *(f32x4*)(Cp + (size_t)i * 128 + d4) = *(const LAS f32x4*)(T + i * 148 + d4); }
    if (tid < 16) Np[tid] = T[tid * 148 + 128];
    if (ic == 0 && tid == 0) out[O_MP + l * 32 + b * 4 + h] = m;
}
}
namespace fk {
constexpr int ATT_LD = 264;
__device__ __forceinline__ void attn_unit(unsigned char* ws, LAS unsigned char* lds, int l, int pm, int h, int wave) {
    const int lane = lane_id_asm(), tid = wave * 64 + lane, fr = lane & 15, g = lane >> 4;
    const int b = pm >> 3;
    const bf16* QA = (const bf16*)(ws + WS_QA); bf16* ATT = (bf16*)(ws + WS_ATT);
    const bf16* KB = (const bf16*)(ws + WS_KB) + (size_t)l * 2097152 + (size_t)b * 256 * 1024 + h * 256;
    const bf16* VTB = (const bf16*)(ws + WS_VTB) + ((size_t)(l * 32 + b * 4 + h)) * 65536;
    { v4u kreg[16];
#pragma unroll
      for (int it = 0; it < 16; ++it) { const int ch = tid + it * NTHR, row = ch >> 5, c16 = ch & 31; kreg[it] = *(const v4u*)(KB + (size_t)row * 1024 + c16 * 8); }
      asm volatile("" ::: "memory");
      LBAR();
#pragma unroll
      for (int it = 0; it < 16; ++it) { const int ch = tid + it * NTHR, row = ch >> 5, c16 = ch & 31; *(LAS v4u*)(lds + row * (ATT_LD * 2) + c16 * 16) = kreg[it]; } }
    LBAR();
    bf16x8 pfr[2][8]; float inv[2];
    {
        const int rowa = pm * 256 + 32 * wave + fr;
        bf16x8 qa[8], qb[8];
#pragma unroll
        for (int st = 0; st < 8; ++st) { qa[st] = *(const bf16x8*)(QA + (size_t)rowa * 1024 + h * 256 + 32 * st + 8 * g); qb[st] = *(const bf16x8*)(QA + (size_t)(rowa + 16) * 1024 + h * 256 + 32 * st + 8 * g); }
        f32x4 sa[16], sb[16];
#pragma unroll
        for (int mt = 0; mt < 16; ++mt) { f32x4 a = (f32x4){0.f, 0.f, 0.f, 0.f}, c = a;
#pragma unroll
            for (int st = 0; st < 8; ++st) { const bf16x8 kf = *(const LAS bf16x8*)(lds + (16 * mt + fr) * (ATT_LD * 2) + (32 * st + 8 * g) * 2); a = MFMA16(kf, qa[st], a); c = MFMA16(kf, qb[st], c); }
            sa[mt] = a; sb[mt] = c; __builtin_amdgcn_sched_barrier(0); }
#define ATT_SOFTMAX(SV, TT) do { float mx = -3.0e38f; \
            _Pragma("unroll") for (int mt = 0; mt < 16; ++mt) mx = fmaxf(fmaxf(mx, fmaxf(SV[mt][0], SV[mt][1])), fmaxf(SV[mt][2], SV[mt][3])); \
            mx = fmaxf(mx, __shfl_xor(mx, 16)); mx = fmaxf(mx, __shfl_xor(mx, 32)); float sum = 0.f; \
            _Pragma("unroll") for (int mt = 0; mt < 16; ++mt) { _Pragma("unroll") for (int r = 0; r < 4; ++r) { const float p = __expf(SV[mt][r] - mx); SV[mt][r] = p; sum += p; } } \
            sum += __shfl_xor(sum, 16); sum += __shfl_xor(sum, 32); inv[TT] = __builtin_amdgcn_rcpf(sum); \
            _Pragma("unroll") for (int st = 0; st < 8; ++st) { const v4u w = (v4u){cvtpk(SV[2 * st][0], SV[2 * st][1]), cvtpk(SV[2 * st][2], SV[2 * st][3]), cvtpk(SV[2 * st + 1][0], SV[2 * st + 1][1]), cvtpk(SV[2 * st + 1][2], SV[2 * st + 1][3])}; \
                pfr[TT][st] = __builtin_bit_cast(bf16x8, w); } \
            __builtin_amdgcn_sched_barrier(0); } while (0)
        ATT_SOFTMAX(sa, 0);
        ATT_SOFTMAX(sb, 1);
#undef ATT_SOFTMAX
    }
    { const int tidb = wave * 64 + lane_id_asm();
      v4u vreg[16];
#pragma unroll
      for (int it = 0; it < 16; ++it) { const int ch = tidb + it * NTHR, row = ch >> 5, c16 = ch & 31; vreg[it] = *(const v4u*)(VTB + (size_t)row * 256 + c16 * 8); }
      asm volatile("" ::: "memory");
      LBAR();
#pragma unroll
      for (int it = 0; it < 16; ++it) { const int ch = tidb + it * NTHR, row = ch >> 5, c16 = ch & 31; *(LAS v4u*)(lds + row * (ATT_LD * 2) + c16 * 16) = vreg[it]; } }
    LBAR();
    const int lane2 = lane_id_asm(), fr2 = lane2 & 15, g2 = lane2 >> 4;
    const int row0 = pm * 256 + 32 * wave + fr2;
#pragma unroll 2
    for (int dt = 0; dt < 16; ++dt) { f32x4 a0 = (f32x4){0.f, 0.f, 0.f, 0.f}, a1 = a0;
#pragma unroll
        for (int st = 0; st < 8; ++st) { const LAS unsigned char* p = lds + (16 * dt + fr) * (ATT_LD * 2) + (32 * st + 4 * g) * 2;
            const v2u lo = *(const LAS v2u*)p, hi = *(const LAS v2u*)(p + 32); const v4u w = (v4u){lo[0], lo[1], hi[0], hi[1]}; const bf16x8 vf = __builtin_bit_cast(bf16x8, w);
            a0 = MFMA16(vf, pfr[0][st], a0); a1 = MFMA16(vf, pfr[1][st], a1); }
        *(v2u*)(ATT + (size_t)row0 * 1024 + h * 256 + 16 * dt + 4 * g2) = pack4(a0[0] * inv[0], a0[1] * inv[0], a0[2] * inv[0], a0[3] * inv[0]);
        *(v2u*)(ATT + (size_t)(row0 + 16) * 1024 + h * 256 + 16 * dt + 4 * g2) = pack4(a1[0] * inv[1], a1[1] * inv[1], a1[2] * inv[1], a1[3] * inv[1]);
        __builtin_amdgcn_sched_barrier(0); }
}
__device__ __forceinline__ void final_norm_rows(const bf16* XB, const float* SSQ, const float* gf, float* yp, float* ys, int gw_, int NGW, int xg) {
    const int lane = lane_id_asm(); int gw = gw_; asm volatile("" : "+s"(gw));
    const int LIM = xg < 0 ? MT : SEQ + 16;
    for (int i = gw; i < LIM; i += 2 * NGW) {
        const int i2 = (i + NGW < LIM) ? i + NGW : i;
        const int r = xg < 0 ? i : (i < SEQ ? SEQ * xg + i : M + 16 * xg + (i - SEQ)), r2 = xg < 0 ? i2 : (i2 < SEQ ? SEQ * xg + i2 : M + 16 * xg + (i2 - SEQ));
        v4u xa[2], xb[2]; f32x4 gv[4];
#pragma unroll
        for (int j = 0; j < 2; ++j) { xa[j] = *(const v4u*)(XB + (size_t)r * D + 8 * lane + 512 * j); xb[j] = *(const v4u*)(XB + (size_t)r2 * D + 8 * lane + 512 * j);
            gv[2 * j] = *(const f32x4*)(gf + 8 * lane + 512 * j); gv[2 * j + 1] = *(const f32x4*)(gf + 8 * lane + 512 * j + 4); }
        asm volatile("" ::: "memory");
        float sa = 0.f, sb = 0.f;
#pragma unroll
        for (int j = 0; j < 2; ++j)
#pragma unroll
            for (int e = 0; e < 4; ++e) { const float a0 = __builtin_bit_cast(float, xa[j][e] << 16), a1 = __builtin_bit_cast(float, xa[j][e] & 0xffff0000u), b0 = __builtin_bit_cast(float, xb[j][e] << 16), b1 = __builtin_bit_cast(float, xb[j][e] & 0xffff0000u); sa += a0 * a0 + a1 * a1; sb += b0 * b0 + b1 * b1; }
        const float ra = rsqrtf(wave_sum(sa) * (1.f / 1024.f) + EPS), rb = rsqrtf(wave_sum(sb) * (1.f / 1024.f) + EPS);
        float* da = r < M ? yp + (size_t)r * D : ys + (size_t)(r - M) * D; float* db = r2 < M ? yp + (size_t)r2 * D : ys + (size_t)(r2 - M) * D;
#pragma unroll
        for (int j = 0; j < 2; ++j) {
            f32x4 a0, a1, b0, b1;
#pragma unroll
            for (int e = 0; e < 2; ++e) { a0[2 * e] = __builtin_bit_cast(float, xa[j][e] << 16); a0[2 * e + 1] = __builtin_bit_cast(float, xa[j][e] & 0xffff0000u); a1[2 * e] = __builtin_bit_cast(float, xa[j][2 + e] << 16); a1[2 * e + 1] = __builtin_bit_cast(float, xa[j][2 + e] & 0xffff0000u);
                                           b0[2 * e] = __builtin_bit_cast(float, xb[j][e] << 16); b0[2 * e + 1] = __builtin_bit_cast(float, xb[j][e] & 0xffff0000u); b1[2 * e] = __builtin_bit_cast(float, xb[j][2 + e] << 16); b1[2 * e + 1] = __builtin_bit_cast(float, xb[j][2 + e] & 0xffff0000u); }
            *(f32x4*)(da + 8 * lane + 512 * j) = a0 * ra * gv[2 * j]; *(f32x4*)(da + 8 * lane + 512 * j + 4) = a1 * ra * gv[2 * j + 1];
            if (r2 != r) { *(f32x4*)(db + 8 * lane + 512 * j) = b0 * rb * gv[2 * j]; *(f32x4*)(db + 8 * lane + 512 * j + 4) = b1 * rb * gv[2 * j + 1]; } }
    }
}
}
namespace fk {
constexpr size_t WS_PROJS = WS_SAMP, WS_YMIXS = WS_SAMP + 1 * MiB, WS_QS = WS_SAMP + 2 * MiB, WS_ATTS = WS_SAMP + 3 * MiB, WS_HMIDS = WS_SAMP + 4 * MiB;
__device__ __forceinline__ float block_sum512(float v, LAS float* red, int wave, int lane) {
    v = wave_sum(v); if (lane == 0) red[wave] = v; __syncthreads();
    float s = ((red[0] + red[1]) + (red[2] + red[3])) + ((red[4] + red[5]) + (red[6] + red[7])); __syncthreads(); return s;
}
template <int MODE, int NT>
__device__ __forceinline__ void skinny_unit(unsigned char* ws, LAS unsigned char* lds, const bf16* A, int lda, const bf16* Bt, int K, int rg, int cg, float* outf, int ldo, bf16* outb, int wave) {
    const int lane = lane_id_asm(), tid = wave * 64 + lane, fr = lane & 15, g = lane >> 4;
    constexpr int NC = 16 * NT;
    const int ks = K >> 3, k0 = wave * ks;
    const bf16* ap = A + (size_t)(16 * rg + fr) * lda + k0 + 8 * g;
    const bf16* bp = Bt + (size_t)(NC * cg + fr) * K + k0 + 8 * g;
    constexpr int PR = NC / 2;
    const int row = (tid / PR) & 15, c2 = (tid % PR) * 2, grow = M + 16 * rg + row, col = NC * cg + c2; const bool epi = tid < 16 * PR;
    unsigned xo = 0u; unsigned* XP = (unsigned*)((bf16*)(ws + WS_XB) + (size_t)grow * D + col);
    if (MODE == 1) xo = *XP;
    f32x4 acc[NT]; float ssq = 0.f;
#pragma unroll
    for (int nt = 0; nt < NT; ++nt) acc[nt] = (f32x4){0.f, 0.f, 0.f, 0.f};
    for (int kk = 0; kk < ks; kk += 128) {
        bf16x8 af[4], bfr[NT][4];
#pragma unroll
        for (int st = 0; st < 4; ++st) { af[st] = *(const bf16x8*)(ap + kk + 32 * st);
#pragma unroll
            for (int nt = 0; nt < NT; ++nt) bfr[nt][st] = *(const bf16x8*)(bp + (size_t)(16 * nt) * K + kk + 32 * st); }
        if (MODE != 1) {
#pragma unroll
            for (int st = 0; st < 4; ++st) { const v4u w = __builtin_bit_cast(v4u, af[st]);
#pragma unroll
                for (int e = 0; e < 4; ++e) { const float lo = __builtin_bit_cast(float, w[e] << 16), hi = __builtin_bit_cast(float, w[e] & 0xffff0000u); ssq += lo * lo + hi * hi; } } }
#pragma unroll
        for (int st = 0; st < 4; ++st)
#pragma unroll
            for (int nt = 0; nt < NT; ++nt) acc[nt] = MFMA16(bfr[nt][st], af[st], acc[nt]);
    }
    LBAR();
    LAS float* red = (LAS float*)lds;
    LAS float* rsq = red + 8 * 16 * NC;
#pragma unroll
    for (int nt = 0; nt < NT; ++nt) *(LAS f32x4*)(red + wave * (16 * NC) + fr * NC + 16 * nt + 4 * g) = acc[nt];
    if (MODE != 1) { ssq += __shfl_xor(ssq, 16); ssq += __shfl_xor(ssq, 32); if (g == 0) rsq[wave * 16 + fr] = ssq; }
    LBAR();
    if (!epi) return;
    float v0 = 0.f, v1 = 0.f;
#pragma unroll
    for (int w = 0; w < 8; ++w) { const f32x2 p = *(const LAS f32x2*)(red + w * (16 * NC) + row * NC + c2); v0 += p[0]; v1 += p[1]; }
    float rs = 1.f;
    if (MODE != 1) { float t = 0.f;
#pragma unroll
        for (int w = 0; w < 8; ++w) t += rsq[w * 16 + row];
        rs = rsqrtf(t * (1.f / 1024.f) + EPS); }
    if (MODE == 0) { *(f32x2*)(outf + (size_t)(16 * rg + row) * ldo + col) = (f32x2){v0 * rs, v1 * rs}; }
    else if (MODE == 2) { const float a = fmaxf(v0 * rs, 0.f), b = fmaxf(v1 * rs, 0.f);
        *(unsigned*)(outb + (size_t)(16 * rg + row) * ldo + col) = cvtpk(a * a, b * b); }
    else { const float x0 = __builtin_bit_cast(float, xo << 16) + v0, x1 = __builtin_bit_cast(float, xo & 0xffff0000u) + v1; *XP = cvtpk(x0, x1); }
}
struct PreSkinnyResid { unsigned char* ws; LAS unsigned char* lds; const bf16* A; const bf16* Bt; int K, vcu, G, wave;
    __device__ __forceinline__ void operator()() const { for (int u = vcu; u < 256; u += G) skinny_unit<1, 2>(ws, lds + 32768, A, K, Bt, K, u >> 5, u & 31, nullptr, 0, nullptr, wave); LBAR(); } };
__device__ __forceinline__ void skinny_pair_up(unsigned char* ws, LAS unsigned char* lds, const bf16* A, const bf16* Bt, int rg, int cg, bf16* outb, int wave) {
    const int lane = lane_id_asm(), tid = wave * 64 + lane, fr = lane & 15, g = lane >> 4;
    constexpr int K = 1024, NT = 4, NC = 64, ldo = 4096;
    const int k0 = wave * 128;
    const bf16* bp = Bt + (size_t)(NC * cg + fr) * K + k0 + 8 * g;
    bf16x8 af[2][4], bfr[NT][4];
#pragma unroll
    for (int st = 0; st < 4; ++st) {
#pragma unroll
        for (int q = 0; q < 2; ++q) af[q][st] = *(const bf16x8*)(A + (size_t)(16 * (rg + 4 * q) + fr) * K + k0 + 8 * g + 32 * st);
#pragma unroll
        for (int nt = 0; nt < NT; ++nt) bfr[nt][st] = *(const bf16x8*)(bp + (size_t)(16 * nt) * K + 32 * st); }
    f32x4 acc[2][NT]; float ssq[2];
#pragma unroll
    for (int q = 0; q < 2; ++q) { ssq[q] = 0.f;
#pragma unroll
        for (int nt = 0; nt < NT; ++nt) acc[q][nt] = (f32x4){0.f, 0.f, 0.f, 0.f};
#pragma unroll
        for (int st = 0; st < 4; ++st) { const v4u w = __builtin_bit_cast(v4u, af[q][st]);
#pragma unroll
            for (int e = 0; e < 4; ++e) { const float lo = __builtin_bit_cast(float, w[e] << 16), hi = __builtin_bit_cast(float, w[e] & 0xffff0000u); ssq[q] += lo * lo + hi * hi; }
#pragma unroll
            for (int nt = 0; nt < NT; ++nt) acc[q][nt] = MFMA16(bfr[nt][st], af[q][st], acc[q][nt]); } }
    LBAR();
    LAS float* red = (LAS float*)lds;
    LAS float* rsq = red + 2 * 8 * 16 * NC;
#pragma unroll
    for (int q = 0; q < 2; ++q) {
#pragma unroll
        for (int nt = 0; nt < NT; ++nt) *(LAS f32x4*)(red + (q * 8 + wave) * (16 * NC) + fr * NC + 16 * nt + 4 * g) = acc[q][nt];
        float t = ssq[q]; t += __shfl_xor(t, 16); t += __shfl_xor(t, 32); if (g == 0) rsq[(q * 8 + wave) * 16 + fr] = t; }
    LBAR();
    const int row = tid >> 5, c2 = (tid & 31) * 2, col = NC * cg + c2;
#pragma unroll
    for (int q = 0; q < 2; ++q) { float v0 = 0.f, v1 = 0.f, t = 0.f;
#pragma unroll
        for (int w = 0; w < 8; ++w) { const f32x2 p = *(const LAS f32x2*)(red + (q * 8 + w) * (16 * NC) + row * NC + c2); v0 += p[0]; v1 += p[1]; t += rsq[(q * 8 + w) * 16 + row]; }
        const float rs = rsqrtf(t * (1.f / 1024.f) + EPS); const float a = fmaxf(v0 * rs, 0.f), b = fmaxf(v1 * rs, 0.f);
        *(unsigned*)(outb + (size_t)(16 * (rg + 4 * q) + row) * ldo + col) = cvtpk(a * a, b * b); }
}
__device__ __forceinline__ void sample_mix_unit(const float* const* in, unsigned char* ws, float* out, LAS unsigned char* lds, int l, int b, int h, int wave) {
    const int lane = lane_id_asm(), tid = wave * 64 + lane;
    LAS float* red = (LAS float*)lds; LAS float* sconv = red + 16; LAS float* sxm = sconv + 128; LAS float* sq = sxm + 128; LAS float* sk = sq + 128; LAS float* sv = sk + 128; LAS float* snum = sv + 128;
    const float* PROJ = (const float*)(ws + WS_PROJS) + (size_t)b * 2048; bf16* YM = (bf16*)(ws + WS_YMIXS) + (size_t)b * 1024; const float* GATES = (const float*)(ws + WS_GATES) + (size_t)(M + b) * 8;
    const int v = tid & 127, kg = tid >> 7; const size_t so = ((size_t)(l * 128 + b) * 4 + h) * 16384;
    const float* C0 = in[5] + so + (size_t)(kg * 32) * 128 + v; float c0v[32];
#pragma unroll
    for (int kk = 0; kk < 32; ++kk) c0v[kk] = __builtin_nontemporal_load(C0 + kk * 128);
    const float* Wq = in[16] + (size_t)l * 65536 + (size_t)h * 16384 + (size_t)(32 * kg) * 128 + v; const float* Wk = in[17] + (size_t)l * 65536 + (size_t)h * 16384 + (size_t)(32 * kg) * 128 + v;
    const float* Wv = in[18] + (size_t)l * 65536 + (size_t)h * 16384 + (size_t)(32 * kg) * 128 + v;
    float wqv[32], wkv[32], wvv[32];
#pragma unroll
    for (int d = 0; d < 32; ++d) { wqv[d] = Wq[d * 128]; wkv[d] = Wk[d * 128]; wvv[d] = Wv[d * 128]; }
    const float pv_raw = PROJ[512 + tid], pu_raw = PROJ[tid];
    float xm = 0.f, s0 = 0.f, s1 = 0.f, s2 = 0.f, cw0 = 0.f, cw1 = 0.f, cw2 = 0.f, cw3 = 0.f, cbv = 0.f, opre = 0.f, n0v = 0.f;
    if (tid < 128) { const int c = h * 128 + tid; xm = PROJ[1024 + c]; opre = PROJ[1536 + c]; const float* sc = in[8] + ((size_t)(l * 128 + b) * 3) * 512 + c; const float* cw = in[14] + (size_t)l * 2048 + c;
        s0 = sc[0]; s1 = sc[512]; s2 = sc[1024]; cw0 = cw[0]; cw1 = cw[512]; cw2 = cw[1024]; cw3 = cw[1536]; cbv = in[15][l * 512 + c]; n0v = in[6][((size_t)(l * 128 + b) * 4 + h) * 128 + tid]; }
    const float ig = GATES[h] + in[19][l * 4 + h]; const float z = GATES[4 + h] + in[20][l * 4 + h]; const float m0 = in[7][l * 512 + b * 4 + h];
    const float gvg = in[11][l * 512 + tid], ws00 = in[12][(size_t)l * 65536 + (size_t)h * 16384], bs0 = in[13][l * 512 + h * 128];
    float ogv = 0.f, skv = 0.f; if (tid < 128) { ogv = in[21][l * 512 + h * 128 + tid]; skv = in[22][l * 512 + h * 128 + tid]; }
    asm volatile("" ::: "memory");
    LBAR();
    const float vraw = gelu_f(pv_raw);
    { float t = wave_sum(vraw * vraw); if (lane == 0) red[wave] = t; }
    if (tid < 128) { const float a = cbv + cw0 * s0 + cw1 * s1 + cw2 * s2 + cw3 * xm; sconv[tid] = a * sigmoid_f(a); sxm[tid] = xm; }
    LBAR();
    const float rsv = rsqrtf((((red[0] + red[1]) + (red[2] + red[3])) + ((red[4] + red[5]) + (red[6] + red[7]))) * (1.f / 512.f) + EPS);
    const float vn = vraw * rsv * gvg;
    if (h == 0) out[O_GV + (size_t)l * 65536 + b * 512 + tid] = vn;
    if ((tid >> 7) == h) YM[tid] = (bf16)f2bf(gelu_f(pu_raw) * (ws00 * vn + bs0));
    if (tid < 128) { float* co = out + O_CVS + (size_t)l * 196608 + (size_t)b * 1536 + h * 128 + tid; co[0] = s1; co[512] = s2; co[1024] = xm; }
    {
        float pq = 0.f, pk = 0.f, pvv = 0.f;
#pragma unroll
        for (int d = 0; d < 32; ++d) { const float c = sconv[32 * kg + d]; pq += c * wqv[d]; pk += c * wkv[d]; pvv += sxm[32 * kg + d] * wvv[d]; }
        snum[tid] = pq; snum[512 + tid] = pk; snum[1024 + tid] = pvv; }
    LBAR();
    if (tid < 384) { const int which = tid >> 7, e = tid & 127; const LAS float* pp = snum + which * 512 + e; const float a = (pp[0] + pp[128]) + (pp[256] + pp[384]);
        if (which == 0) sq[e] = a; else if (which == 1) sk[e] = a * 0.08838834764831845f; else sv[e] = a; }
    const float lf = fminf(z, 0.f) - __logf(1.f + __expf(-fabsf(z)));
    const float mn = fmaxf(lf + m0, ig), fd = __expf(lf + m0 - mn), iw = __expf(ig - mn);
    LBAR();
    float num = 0.f;
    {
        float* Co = out + O_CS + so + (size_t)(kg * 32) * 128 + v; const float ivv = iw * sv[v];
#pragma unroll
        for (int kk = 0; kk < 32; ++kk) { const float c = fd * c0v[kk] + sk[kg * 32 + kk] * ivv; __builtin_nontemporal_store(c, Co + kk * 128); num += sq[kg * 32 + kk] * c; }
    }
    float dp = 0.f;
    if (tid < 128) { const float nn = fd * n0v + iw * sk[tid]; out[O_NS + ((size_t)(l * 128 + b) * 4 + h) * 128 + tid] = nn; dp = sq[tid] * nn; }
    dp = wave_sum(dp);
    LBAR();
    snum[kg * 128 + v] = num; if (lane == 0) red[wave] = dp;
    LBAR();
    const float den = red[0] + red[1];
    float hv = 0.f;
    if (tid < 128) hv = ((snum[tid] + snum[128 + tid]) + (snum[256 + tid] + snum[384 + tid])) * __builtin_amdgcn_rcpf(fmaxf(fabsf(den), __expf(-mn)));
    { float t = wave_sum(hv * hv); if (lane == 0) red[8 + wave] = t; }
    LBAR();
    const float rs = rsqrtf((red[8] + red[9]) * (1.f / 128.f) + EPS);
    if (tid < 128) { const int c = h * 128 + tid;
        YM[512 + c] = (bf16)f2bf(sigmoid_f(opre) * (hv * rs * ogv + skv * sconv[tid]));
        if (tid == 0) out[O_MS + l * 512 + b * 4 + h] = mn; }
}
__device__ __forceinline__ void sample_mix_pair(const float* const* in, unsigned char* ws, float* out, LAS unsigned char* lds, int l, int bA, int bB, int h, int wave) {
    const int lane = lane_id_asm(), tid = wave * 64 + lane;
    constexpr int LQ = 12288;
    const int v = tid & 127, kg = tid >> 7;
    int bb[2]; bb[0] = bA; bb[1] = bB;
    const float* Wq = in[16] + (size_t)l * 65536 + (size_t)h * 16384 + (size_t)(32 * kg) * 128 + v; const float* Wk = in[17] + (size_t)l * 65536 + (size_t)h * 16384 + (size_t)(32 * kg) * 128 + v;
    const float* Wv = in[18] + (size_t)l * 65536 + (size_t)h * 16384 + (size_t)(32 * kg) * 128 + v;
    float wqv[32], wkv[32], wvv[32];
#pragma unroll
    for (int d = 0; d < 32; ++d) { wqv[d] = Wq[d * 128]; wkv[d] = Wk[d * 128]; wvv[d] = Wv[d * 128]; }
    float cw0 = 0.f, cw1 = 0.f, cw2 = 0.f, cw3 = 0.f, cbv = 0.f, ogv = 0.f, skv = 0.f;
    if (tid < 128) { const int c = h * 128 + tid; const float* cw = in[14] + (size_t)l * 2048 + c; cw0 = cw[0]; cw1 = cw[512]; cw2 = cw[1024]; cw3 = cw[1536]; cbv = in[15][l * 512 + c]; ogv = in[21][l * 512 + c]; skv = in[22][l * 512 + c]; }
    const float gvg = in[11][l * 512 + tid], ws00 = in[12][(size_t)l * 65536 + (size_t)h * 16384], bs0 = in[13][l * 512 + h * 128], bi = in[19][l * 4 + h], bfv = in[20][l * 4 + h];
    float c0v[2][32], pv_raw[2], pu_raw[2], xm[2], s0[2], s1[2], s2[2], opre[2], n0v[2], gi[2], gz[2], m0[2];
#pragma unroll
    for (int q = 0; q < 2; ++q) { const int b = bb[q]; const size_t so = ((size_t)(l * 128 + b) * 4 + h) * 16384;
        const float* C0 = in[5] + so + (size_t)(kg * 32) * 128 + v;
#pragma unroll
        for (int kk = 0; kk < 32; ++kk) c0v[q][kk] = __builtin_nontemporal_load(C0 + kk * 128);
        const float* PROJ = (const float*)(ws + WS_PROJS) + (size_t)b * 2048; const float* GATES = (const float*)(ws + WS_GATES) + (size_t)(M + b) * 8;
        pv_raw[q] = PROJ[512 + tid]; pu_raw[q] = PROJ[tid];
        xm[q] = 0.f; s0[q] = 0.f; s1[q] = 0.f; s2[q] = 0.f; opre[q] = 0.f; n0v[q] = 0.f;
        if (tid < 128) { const int c = h * 128 + tid; xm[q] = PROJ[1024 + c]; opre[q] = PROJ[1536 + c]; const float* sc = in[8] + ((size_t)(l * 128 + b) * 3) * 512 + c;
            s0[q] = sc[0]; s1[q] = sc[512]; s2[q] = sc[1024]; n0v[q] = in[6][((size_t)(l * 128 + b) * 4 + h) * 128 + tid]; }
        gi[q] = GATES[h]; gz[q] = GATES[4 + h]; m0[q] = in[7][l * 512 + b * 4 + h]; }
    asm volatile("" ::: "memory");
    LBAR();
    float vraw[2];
#pragma unroll
    for (int q = 0; q < 2; ++q) { LAS float* red = (LAS float*)(lds + q * LQ); LAS float* sconv = red + 16; LAS float* sxm = sconv + 128;
        vraw[q] = gelu_f(pv_raw[q]);
        { float t = wave_sum(vraw[q] * vraw[q]); if (lane == 0) red[wave] = t; }
        if (tid < 128) { const float a = cbv + cw0 * s0[q] + cw1 * s1[q] + cw2 * s2[q] + cw3 * xm[q]; sconv[tid] = a * sigmoid_f(a); sxm[tid] = xm[q]; } }
    LBAR();
#pragma unroll
    for (int q = 0; q < 2; ++q) { const int b = bb[q]; LAS float* red = (LAS float*)(lds + q * LQ); LAS float* sconv = red + 16; LAS float* sxm = sconv + 128; LAS float* snum = sxm + 128 + 384;
        bf16* YM = (bf16*)(ws + WS_YMIXS) + (size_t)b * 1024;
        const float rsv = rsqrtf((((red[0] + red[1]) + (red[2] + red[3])) + ((red[4] + red[5]) + (red[6] + red[7]))) * (1.f / 512.f) + EPS);
        const float vn = vraw[q] * rsv * gvg;
        if (h == 0) out[O_GV + (size_t)l * 65536 + b * 512 + tid] = vn;
        if ((tid >> 7) == h) YM[tid] = (bf16)f2bf(gelu_f(pu_raw[q]) * (ws00 * vn + bs0));
        if (tid < 128) { float* co = out + O_CVS + (size_t)l * 196608 + (size_t)b * 1536 + h * 128 + tid; co[0] = s1[q]; co[512] = s2[q]; co[1024] = xm[q]; }
        float pq = 0.f, pk = 0.f, pvv = 0.f;
#pragma unroll
        for (int d = 0; d < 32; ++d) { const float c = sconv[32 * kg + d]; pq += c * wqv[d]; pk += c * wkv[d]; pvv += sxm[32 * kg + d] * wvv[d]; }
        snum[tid] = pq; snum[512 + tid] = pk; snum[1024 + tid] = pvv; }
    LBAR();
#pragma unroll
    for (int q = 0; q < 2; ++q) { LAS float* red = (LAS float*)(lds + q * LQ); LAS float* sq = red + 16 + 256; LAS float* sk = sq + 128; LAS float* sv = sk + 128; LAS float* snum = sv + 128;
        if (tid < 384) { const int which = tid >> 7, e = tid & 127; const LAS float* pp = snum + which * 512 + e; const float a = (pp[0] + pp[128]) + (pp[256] + pp[384]);
            if (which == 0) sq[e] = a; else if (which == 1) sk[e] = a * 0.08838834764831845f; else sv[e] = a; } }
    LBAR();
    float num[2], dpv[2], mnv[2];
#pragma unroll
    for (int q = 0; q < 2; ++q) { const int b = bb[q]; LAS float* red = (LAS float*)(lds + q * LQ); LAS float* sq = red + 16 + 256; LAS float* sk = sq + 128; LAS float* sv = sk + 128;
        const float ig = gi[q] + bi, z = gz[q] + bfv; const float lf = fminf(z, 0.f) - __logf(1.f + __expf(-fabsf(z)));
        const float mn = fmaxf(lf + m0[q], ig), fd = __expf(lf + m0[q] - mn), iw = __expf(ig - mn); mnv[q] = mn;
        const size_t so = ((size_t)(l * 128 + b) * 4 + h) * 16384; float* Co = out + O_CS + so + (size_t)(kg * 32) * 128 + v; const float ivv = iw * sv[v];
        float nm = 0.f;
#pragma unroll
        for (int kk = 0; kk < 32; ++kk) { const float c = fd * c0v[q][kk] + sk[kg * 32 + kk] * ivv; __builtin_nontemporal_store(c, Co + kk * 128); nm += sq[kg * 32 + kk] * c; }
        num[q] = nm;
        float dp = 0.f;
        if (tid < 128) { const float nn = fd * n0v[q] + iw * sk[tid]; out[O_NS + ((size_t)(l * 128 + b) * 4 + h) * 128 + tid] = nn; dp = sq[tid] * nn; }
        dpv[q] = wave_sum(dp); }
    LBAR();
#pragma unroll
    for (int q = 0; q < 2; ++q) { LAS float* red = (LAS float*)(lds + q * LQ); LAS float* snum = red + 16 + 256 + 384; snum[kg * 128 + v] = num[q]; if (lane == 0) red[wave] = dpv[q]; }
    LBAR();
    float hv[2];
#pragma unroll
    for (int q = 0; q < 2; ++q) { LAS float* red = (LAS float*)(lds + q * LQ); LAS float* snum = red + 16 + 256 + 384;
        const float den = red[0] + red[1]; hv[q] = 0.f;
        if (tid < 128) hv[q] = ((snum[tid] + snum[128 + tid]) + (snum[256 + tid] + snum[384 + tid])) * __builtin_amdgcn_rcpf(fmaxf(fabsf(den), __expf(-mnv[q])));
        { float t = wave_sum(hv[q] * hv[q]); if (lane == 0) red[8 + wave] = t; } }
    LBAR();
#pragma unroll
    for (int q = 0; q < 2; ++q) { const int b = bb[q]; LAS float* red = (LAS float*)(lds + q * LQ); LAS float* sconv = red + 16; bf16* YM = (bf16*)(ws + WS_YMIXS) + (size_t)b * 1024;
        const float rs = rsqrtf((red[8] + red[9]) * (1.f / 128.f) + EPS);
        if (tid < 128) { const int c = h * 128 + tid; YM[512 + c] = (bf16)f2bf(sigmoid_f(opre[q]) * (hv[q] * rs * ogv + skv * sconv[tid]));
            if (tid == 0) out[O_MS + l * 512 + b * 4 + h] = mnv[q]; } }
}
__device__ __forceinline__ void sample_attn_unit(const float* const* in, unsigned char* ws, LAS unsigned char* lds, int l, int b, int h, int wave) {
    const int lane = lane_id_asm(), tid = wave * 64 + lane;
    LAS float* red = (LAS float*)lds; LAS float* sp = red + 16; LAS float* sacc = sp + 256;
    const float* Kc = in[3] + ((size_t)(l * 128 + b) * 256) * 1024 + h * 256 + 4 * lane; const float* Vc = in[4] + ((size_t)(l * 128 + b) * 256) * 1024 + h * 256 + 4 * lane;
    const f32x4 q = *(const f32x4*)((const float*)(ws + WS_QS) + (size_t)b * 1024 + h * 256 + 4 * lane);
    LBAR();
    float myscore = 0.f;
    {
        f32x4 kv[32];
#pragma unroll
        for (int i = 0; i < 32; ++i) kv[i] = __builtin_nontemporal_load((const f32x4*)(Kc + (size_t)(32 * wave + i) * 1024));
        float dv[32];
#pragma unroll
        for (int i = 0; i < 32; ++i) dv[i] = (kv[i][0] * q[0] + kv[i][1] * q[1]) + (kv[i][2] * q[2] + kv[i][3] * q[3]);
#pragma unroll
        for (int i = 0; i < 16; ++i) { const bool up = (lane & 32) != 0; const float send = up ? dv[i] : dv[i + 16], keep = up ? dv[i + 16] : dv[i]; dv[i] = keep + __shfl_xor(send, 32); }
#pragma unroll
        for (int i = 0; i < 8; ++i) { const bool up = (lane & 16) != 0; const float send = up ? dv[i] : dv[i + 8], keep = up ? dv[i + 8] : dv[i]; dv[i] = keep + __shfl_xor(send, 16); }
#pragma unroll
        for (int i = 0; i < 4; ++i) { const bool up = (lane & 8) != 0; const float send = up ? dv[i] : dv[i + 4], keep = up ? dv[i + 4] : dv[i]; dv[i] = keep + __shfl_xor(send, 8); }
#pragma unroll
        for (int i = 0; i < 2; ++i) { const bool up = (lane & 4) != 0; const float send = up ? dv[i] : dv[i + 2], keep = up ? dv[i + 2] : dv[i]; dv[i] = keep + __shfl_xor(send, 4); }
        { const bool up = (lane & 2) != 0; const float send = up ? dv[0] : dv[1], keep = up ? dv[1] : dv[0]; dv[0] = keep + __shfl_xor(send, 2); }
        myscore = dv[0] + __shfl_xor(dv[0], 1);
    }
    f32x4 vv[32];
#pragma unroll
    for (int i = 0; i < 32; ++i) vv[i] = __builtin_nontemporal_load((const f32x4*)(Vc + (size_t)(32 * wave + i) * 1024));
    asm volatile("" ::: "memory");
    if (!(lane & 1)) sp[32 * wave + (lane >> 1)] = myscore;
    LBAR();
    float s = tid < 256 ? sp[tid] : -3.0e38f; float mx = s;
#pragma unroll
    for (int o = 1; o < 64; o <<= 1) mx = fmaxf(mx, __shfl_xor(mx, o));
    if (lane == 0) red[wave] = mx;
    LBAR();
    mx = fmaxf(fmaxf(red[0], red[1]), fmaxf(red[2], red[3]));
    const float p = tid < 256 ? __expf(s - mx) : 0.f;
    { const float t = wave_sum(p); if (lane == 0) red[8 + wave] = t; }
    LBAR();
    const float tot = ((red[8] + red[9]) + (red[10] + red[11])) + ((red[12] + red[13]) + (red[14] + red[15]));
    if (tid < 256) sp[tid] = p * __builtin_amdgcn_rcpf(tot);
    LBAR();
    f32x4 acc = (f32x4){0.f, 0.f, 0.f, 0.f};
#pragma unroll
    for (int i = 0; i < 32; ++i) acc += vv[i] * sp[32 * wave + i];
    *(LAS f32x4*)(sacc + wave * 256 + 4 * lane) = acc;
    LBAR();
    if (tid < 256) { float a = 0.f;
#pragma unroll
        for (int w = 0; w < 8; ++w) a += sacc[w * 256 + tid];
        ((bf16*)(ws + WS_ATTS))[(size_t)b * 1024 + h * 256 + tid] = (bf16)f2bf(a); }
}
}
namespace fk {
constexpr int PH_PREP = 0, PH_MEMKV = 1, PH_L0 = 2, PH_PER_LAYER = 10, PH_FINAL = 22, NPH = 23;
constexpr int LP_G1 = 0, LP_M1 = 1, LP_SCAN = 2, LP_M2 = 3, LP_G2 = 4, LP_G3 = 5, LP_ATT = 6, LP_G4 = 7, LP_G5 = 8, LP_G6 = 9;
struct Args { const float* in[34]; float* out; unsigned char* ws; int ph_lo, ph_hi, region, pad; };

__global__ void __launch_bounds__(NTHR, 2) fwd(Args a) {
    extern __shared__ __attribute__((aligned(16))) unsigned char lds_raw[];
    LAS unsigned char* lds = (LAS unsigned char*)lds_raw;
    volatile LAS unsigned* MISC = (volatile LAS unsigned*)(lds + MISC_OFF);
    const int tid = threadIdx.x, wave = __builtin_amdgcn_readfirstlane(tid >> 6);
    const int G = gridDim.x, bx = blockIdx.x;
    const int vcu = (G % 8 == 0) ? (bx % 8) * (G / 8) + bx / 8 : bx;
    unsigned char* ws = a.ws; float* out = a.out;
    unsigned* ctl = (unsigned*)(ws + WS_CTL);
    if (tid < 64) MISC[tid] = 0u;
    if (tid == 0) __hip_atomic_store(ctl + CW_XID + vcu, xb_xcc_id() + 1u, __ATOMIC_RELAXED, __HIP_MEMORY_SCOPE_AGENT);
    __syncthreads();
    XcdBarrier bar = xcd_barrier_post(ctl + CW_BAR + a.region * XCD_BAR_WORDS, MISC + 8);
    const int lo = a.ph_lo, hi = a.ph_hi;
#define IN(k) (lo <= (k) && (k) < hi)
#ifdef FK_STAMPS
#define STAMP(k) do { if (bx == 0 && wave == 0 && lane_id_asm() == 0) ((unsigned long long*)(ctl + 32768))[k] = __builtin_amdgcn_s_memrealtime(); } while (0)
#else
#define STAMP(k) do { } while (0)
#endif
#ifdef FK_STAMPS
#define ARRIVE(k) do { if (wave == 0 && lane_id_asm() == 0) ((unsigned long long*)(ctl + 65536))[(k) * 256 + bx] = __builtin_amdgcn_s_memrealtime(); } while (0)
#else
#define ARRIVE(k) do { } while (0)
#endif
#define SEAM(k) do { if (IN(k) && IN((k) + 1)) { ARRIVE(k); xcd_barrier(bar, wave); } STAMP((k) + 1); } while (0)
#define SEAM_L(k) do { if (IN(k) && IN((k) + 1)) { ARRIVE(k); if (MISC[12] != 0u) xcd_local_barrier(ctl, bar.bar, vcu >> 5, MISC + 8, wave); else xcd_barrier(bar, wave); } STAMP((k) + 1); } while (0)
    STAMP(0);
    const int gw = vcu * NWAVES + wave, NGW = G * NWAVES;

    if (IN(PH_PREP)) { p0_prologue<0>(a.in, ws, lds, gw, NGW, wave); }
    SEAM(PH_PREP);
    if (IN(PH_PREP) && IN(PH_MEMKV) && G == 256) {
        if (wave == 0) { const int ln = lane_id_asm(); bool ok = true;
#pragma unroll
            for (int q = 0; q < 4; ++q) { const int v = 4 * ln + q; const unsigned mine = __hip_atomic_load(ctl + CW_XID + v, __ATOMIC_RELAXED, __HIP_MEMORY_SCOPE_AGENT), head = __hip_atomic_load(ctl + CW_XID + (v & ~31), __ATOMIC_RELAXED, __HIP_MEMORY_SCOPE_AGENT);
                ok = ok && mine != 0u && mine == head; }
            const bool all_ok = __builtin_amdgcn_ballot_w64(ok) == ~0ull;
            if (ln == 0) MISC[12] = all_ok ? 1u : 0u; }
        __syncthreads();
    }
    if (IN(PH_MEMKV)) {
        pg8::Gemm g{(const bf16*)(ws + WS_MB), (const bf16*)(ws + WS_WMEM), 2048, 4096, 1024}; pg8::StaticOrder S; S.init(2048, 4096, G, bx);
        EpiMemKV E{out, (bf16*)(ws + WS_KB), (bf16*)(ws + WS_VTB), (const float*)(ws + WS_SSQM)};
        pg8::gemm_phase<EpiMemKV, pg8::StaticOrder, true, true>(lds, g, S, E, wave);
        if (G == 256 && bx >= 128) p0_prologue<1>(a.in, ws, lds, (bx - 128) * NWAVES + wave, 128 * NWAVES, wave);
        else if (G != 256) p0_prologue<1>(a.in, ws, lds, gw, NGW, wave);
    }
    if (IN(PH_MEMKV)) __syncthreads();
    STAMP(PH_MEMKV + 1);
    unsigned char* const ws0 = ws;
#pragma unroll 1
    for (int l = 0; l < 2; ++l) {
        unsigned char* ws = ws0; asm volatile("" : "+s"(ws));
        const int pb = PH_L0 + PH_PER_LAYER * l;
        if (IN(pb + LP_G1)) { asm volatile("" : "+s"(ws));
            if (l == 0) STAMP(90);
            { const int wg = wave * 32 + (vcu & 31);
              gate_prelude_mfma(ws, lds, l, wg < 128 ? 128 * (vcu >> 5) + wg : (wg == 128 ? 1024 + (vcu >> 5) : 1 << 20), wave); }
            if (l == 0) STAMP(91);
            for (int u = vcu; u < 256; u += G) skinny_unit<0, 4>(ws, lds, (const bf16*)(ws + WS_XB) + (size_t)M * D, 1024, (const bf16*)(ws + WS_WIN) + (size_t)l * 2048 * 1024, 1024, u >> 5, u & 31, (float*)(ws + WS_PROJS), 2048, nullptr, wave);
            __syncthreads();
            pg8::Gemm g{(const bf16*)(ws + WS_XB), (const bf16*)(ws + WS_WIN) + (size_t)l * 2048 * 1024, M, 2048, 1024};
#ifdef FK_STAMPS
            if (l == 0) { g.stamps = (unsigned long long*)(ctl + 32768) + 93; STAMP(92); }
#endif
            pg8::StaticOrder S; S.init(M, 2048, G, bx);
            rstd_table_fill(lds, S, (const float*)(ws + WS_SSQ), wave);
            EpiG1 E{(bf16*)(ws + WS_U), (bf16*)(ws + WS_VG), (bf16*)(ws + WS_XM), (bf16*)(ws + WS_OP), lds, (float*)(ws + WS_SSQV), out + O_CVP + (size_t)l * 12288};
            pg8::gemm_phase<EpiG1, pg8::StaticOrder, true, true>(lds, g, S, E, wave);
        }
        if (l == 0) SEAM(pb + LP_G1); else SEAM_L(pb + LP_G1);
        if (IN(pb + LP_M1)) { asm volatile("" : "+s"(ws));
            const int xg = vcu >> 5, j = vcu & 31;
#pragma unroll 1
            for (int k = 0; k < 4; ++k) { const int kk = (vcu & 1) ? (k + 1) % 4 : k;
                if (kk == 0) sample_mix_pair(a.in, ws, out, lds, l, 16 * xg + (j >> 2), 16 * xg + (j >> 2) + 8, j & 3, wave);
                else if (kk < 3) { const int w = j + 32 * (kk - 1); mlstm_local_unit(a.in, ws, lds, l, xg, w >> 4, w & 15, wave); }
                else gmlp_pair(a.in, ws, lds, l, xg, xg, j >> 2, (j >> 2) + 8, j & 3, wave);
            }
        }
        SEAM_L(pb + LP_M1);
        if (IN(pb + LP_SCAN)) { asm volatile("" : "+s"(ws)); for (int u = vcu; u < 256; u += G) mlstm_scan_unit(ws, out, lds, l, u >> 5, (u >> 3) & 3, u & 7, wave); __syncthreads();
            for (int u = vcu; u < 256; u += G) skinny_unit<1, 2>(ws, lds, (const bf16*)(ws + WS_YMIXS), 1024, (const bf16*)(ws + WS_WOUT) + (size_t)l * 1048576, 1024, u >> 5, u & 31, nullptr, 0, nullptr, wave);
            __syncthreads(); }
        SEAM_L(pb + LP_SCAN);
        if (IN(pb + LP_M2)) { asm volatile("" : "+s"(ws));
            for (int k = 0; k < 2; ++k) { const int w = (vcu & 31) + 32 * k; mlstm_out_unit(a.in, ws, out, lds, l, vcu >> 5, w >> 4, w & 15, wave); }
            __syncthreads();
            for (int u = vcu; u < 256; u += G) skinny_unit<0, 2>(ws, lds, (const bf16*)(ws + WS_XB) + (size_t)M * D, 1024, (const bf16*)(ws + WS_WCQ) + (size_t)l * 1048576, 1024, u >> 5, u & 31, (float*)(ws + WS_QS), 1024, nullptr, wave);
            __syncthreads();
        }
        SEAM_L(pb + LP_M2);
        if (IN(pb + LP_G2)) { asm volatile("" : "+s"(ws));
            pg8::Gemm g{(const bf16*)(ws + WS_YMIX), (const bf16*)(ws + WS_WOUT) + (size_t)l * 1048576, M, 1024, 1024}; pg8::StaticOrder S; S.init(M, 1024, G, bx);
            EpiResid E{(bf16*)(ws + WS_XB), (float*)(ws + WS_SSQ)};
            pg8::gemm_phase<EpiResid, pg8::StaticOrder, true, true>(lds, g, S, E, wave);
        }
        SEAM_L(pb + LP_G2);
        if (IN(pb + LP_ATT)) { asm volatile("" : "+s"(ws));
            pg8::Gemm g{(const bf16*)(ws + WS_XB), (const bf16*)(ws + WS_WCQ) + (size_t)l * 1048576, M, 1024, 1024}; pg8::StaticOrder S; S.init(M, 1024, G, bx);
            EpiScaleBf16<0> E{(bf16*)(ws + WS_QA), 1024, lds};
            pg8::Unit myu; myu.pm = 0; myu.pn = 0; (void)S.next(0, myu);
            const int sstep = (vcu % 3 == 0) ? 0 : ((vcu % 3 == 1) ? 2 : 1);
#pragma unroll 1
            for (int step = 0; step < 3; ++step) {
                if (step == sstep) { for (int k = 0; k < 2; ++k) sample_attn_unit(a.in, ws, lds, l, 16 * (vcu >> 5) + ((vcu & 31) >> 1), 2 * (vcu & 1) + k, wave); __syncthreads(); }
                if (step == 0) { rstd_table_fill(lds, S, (const float*)(ws + WS_SSQ), wave); pg8::gemm_phase<EpiScaleBf16<0>, pg8::StaticOrder, true, true>(lds, g, S, E, wave); __syncthreads(); }
                if (step == 1) attn_unit(ws, lds, l, myu.pm, myu.pn, wave);
            }
            __syncthreads();
        }
        SEAM_L(pb + LP_ATT);
        if (IN(pb + LP_G4)) { asm volatile("" : "+s"(ws));
            pg8::Gemm g{(const bf16*)(ws + WS_ATT), (const bf16*)(ws + WS_WCO) + (size_t)l * 1048576, M, 1024, 1024}; pg8::StaticOrder S; S.init(M, 1024, G, bx);
            EpiResid E{(bf16*)(ws + WS_XB), (float*)(ws + WS_SSQ)};
            PreSkinnyResid P{ws, lds, (const bf16*)(ws + WS_ATTS), (const bf16*)(ws + WS_WCO) + (size_t)l * 1048576, 1024, vcu, G, wave};
            pg8::gemm_phase<EpiResid, pg8::StaticOrder, true, true, PreSkinnyResid>(lds, g, S, E, wave, P);
        }
        SEAM_L(pb + LP_G4);
        if (IN(pb + LP_G5)) { asm volatile("" : "+s"(ws));
            for (int k = 0; k < 2; ++k) skinny_unit<2, 4>(ws, lds, (const bf16*)(ws + WS_XB) + (size_t)M * D, 1024, (const bf16*)(ws + WS_WUP) + (size_t)l * 4194304, 1024, vcu >> 5, (vcu & 31) + 32 * k, nullptr, 4096, (bf16*)(ws + WS_HMIDS), wave);
            __syncthreads();
            pg8::Gemm g{(const bf16*)(ws + WS_XB), (const bf16*)(ws + WS_WUP) + (size_t)l * 4194304, M, 4096, 1024};
#ifdef FK_STAMPS
            if (l == 0) { g.stamps = (unsigned long long*)(ctl + 32768) + 70; STAMP(69); }
#endif
            pg8::StaticOrder S; S.init(M, 4096, G, bx);
            rstd_table_fill(lds, S, (const float*)(ws + WS_SSQ), wave);
            EpiScaleBf16<1> E{(bf16*)(ws + WS_HMID), 4096, lds};
            pg8::gemm_phase<EpiScaleBf16<1>, pg8::StaticOrder, true, true>(lds, g, S, E, wave);
        }
        SEAM_L(pb + LP_G5);
        if (IN(pb + LP_G6)) { asm volatile("" : "+s"(ws));
            pg8::Gemm g{(const bf16*)(ws + WS_HMID), (const bf16*)(ws + WS_WDOWN) + (size_t)l * 4194304, M, 1024, 4096}; pg8::StaticOrder S; S.init(M, 1024, G, bx);
            EpiResid E{(bf16*)(ws + WS_XB), (float*)(ws + WS_SSQ)};
            PreSkinnyResid P{ws, lds, (const bf16*)(ws + WS_HMIDS), (const bf16*)(ws + WS_WDOWN) + (size_t)l * 4194304, 4096, vcu, G, wave};
            pg8::gemm_phase<EpiResid, pg8::StaticOrder, true, true, PreSkinnyResid>(lds, g, S, E, wave, P);
        }
        SEAM_L(pb + LP_G6);
    }
    if (IN(PH_FINAL)) { if (G == 256) final_norm_rows((const bf16*)(ws + WS_XB), (const float*)(ws + WS_SSQ), a.in[33], out + O_YP, out + O_YS, (vcu & 31) * NWAVES + wave, 32 * NWAVES, vcu >> 5);
        else final_norm_rows((const bf16*)(ws + WS_XB), (const float*)(ws + WS_SSQ), a.in[33], out + O_YP, out + O_YS, gw, NGW, -1); __syncthreads(); STAMP(PH_FINAL + 1); }
#ifdef FK_STAMPS
    xcd_barrier(bar, wave); STAMP(30); xcd_barrier(bar, wave); STAMP(31); xcd_barrier(bar, wave); STAMP(32);
#endif
#undef IN
#undef SEAM
}

static int g_grid = 0;
static void launch(hipStream_t st, void* const* d_in, float* out, unsigned char* wsf, int ph_lo, int ph_hi, int region) {
    if (g_grid == 0) {
        int dev = 0, cus = 0;
        if (hipGetDevice(&dev) != hipSuccess || hipDeviceGetAttribute(&cus, hipDeviceAttributeMultiprocessorCount, dev) != hipSuccess) { fprintf(stderr, "kernel_launch: device query failed\n"); g_grid = -1; return; }
        if (hipFuncSetAttribute((const void*)fwd, hipFuncAttributeMaxDynamicSharedMemorySize, LDS_BYTES) != hipSuccess) { fprintf(stderr, "kernel_launch: hipFuncSetAttribute failed\n"); g_grid = -1; return; }
        int per_cu = 0;
        if (hipOccupancyMaxActiveBlocksPerMultiprocessor(&per_cu, (const void*)fwd, NTHR, LDS_BYTES) != hipSuccess || per_cu < 1) fprintf(stderr, "kernel_launch: occupancy query says %d\n", per_cu);
        (void)hipGetLastError();
        if (cus < 256) { fprintf(stderr, "kernel_launch: this kernel needs 256 CUs (found %d)\n", cus); g_grid = -1; return; }
        g_grid = 256;
    }
    if (g_grid < 0) return;
    Args a{};
    for (int i = 0; i < 34; ++i) a.in[i] = (const float*)d_in[i];
    a.out = out; a.ws = wsf; a.ph_lo = ph_lo; a.ph_hi = ph_hi; a.region = region; a.pad = 0;
    hipLaunchKernelGGL(fwd, dim3(g_grid), dim3(NTHR), LDS_BYTES, st, a);
}
}
extern "C" void kernel_launch(void* const* d_in, const int* in_sizes, int n_in, void* d_out, int out_size, void* d_ws, size_t ws_size, hipStream_t stream) {
    using namespace fk;
    if (n_in != 34 || out_size != (int)O_END || ws_size < WS_FAST_END) { fprintf(stderr, "kernel_launch: unexpected problem shape (n_in %d, out %d, ws %zu)\n", n_in, out_size, ws_size); return; }
    (void)hipMemsetAsync((unsigned char*)d_ws + WS_CTL, 0, 32768, stream);
    fk::launch(stream, d_in, (float*)d_out, (unsigned char*)d_ws, 0, NPH, 0);
}
```

```cpp
#include <hip/hip_runtime.h>
#include <cstdio>
#include <cstdint>
namespace pg8 {
#define PG8_LAS __attribute__((address_space(3)))
typedef unsigned short bf16_t;
typedef short bf16x8 __attribute__((ext_vector_type(8)));
typedef float f32x4 __attribute__((ext_vector_type(4)));
typedef unsigned u32x4 __attribute__((ext_vector_type(4)));
constexpr int BM = 256, BK = 64, HALF = 128, HTB = HALF * BK * 2  , STAGE_BYTES = 8 * HTB, NXCD = 8, WGM = 8;

__host__ __device__ __forceinline__ int lds_byte(int r, int c) { const int st = (r >> 4) * 2 + (c >> 5), rr = r & 15, cc = c & 31, ob = rr * 64 + cc * 2; return st * 1024 + (ob ^ (((ob >> 9) & 1) << 5)); }
__host__ __device__ __forceinline__ void stage_rc(int b, int& R, int& C) { const int st = b / 1024, sb = b % 1024, swz = sb ^ (((sb >> 9) & 1) << 5); R = (st >> 1) * 16 + swz / 64; C = (st & 1) * 32 + (swz % 64) / 2; }
__host__ __device__ __forceinline__ int perm32(int rho) { const int n = rho >> 4, i = rho & 15; return 8 * (i >> 2) + 4 * n + (i & 3); }

struct Unit { int pm, pn; };
struct Gemm { const bf16_t* A; const bf16_t* Bt; int M, N, K; unsigned long long* stamps = nullptr; };

struct StaticOrder {
    int nM, nN, nwg, G, c;
    __host__ __device__ __forceinline__ void init(int M, int N, int G_, int c_) { nM = M / BM; nN = N / BM; nwg = nM * nN; G = G_; c = c_; }
    __host__ __device__ __forceinline__ bool next(int i, Unit& u) const {
        const long L = (long)i * G + c; if (L >= nwg) return false;
        int wgid = (int)L; { const int q = nwg / NXCD, r = nwg % NXCD, xcd = wgid % NXCD, off = wgid / NXCD; wgid = (xcd < r ? xcd * (q + 1) : r * (q + 1) + (xcd - r) * q) + off; }
        const int nig = WGM * nN, gid = wgid / nig, fm = gid * WGM, gsz = (nM - fm) < WGM ? (nM - fm) : WGM;
        u.pm = fm + ((wgid % nig) % gsz); u.pn = (wgid % nig) / gsz; return true;
    }
    __device__ __forceinline__ void a_ready(const Unit&) const {}
    __device__ __forceinline__ void done(const Unit&) const {}
};

__device__ __forceinline__ unsigned cvt_pk_bf16(float lo, float hi) { unsigned r; asm volatile("v_cvt_pk_bf16_f32 %0, %1, %2" : "=v"(r) : "v"(lo), "v"(hi)); return r; }
struct NoPre { __device__ __forceinline__ void operator()() const {} };
template <class Epi, class Sched, bool ALIGN_EPI = false, bool SP2 = false, class Pre = NoPre>
__device__ __forceinline__ void gemm_phase(PG8_LAS unsigned char* lds, const Gemm g, const Sched& S, const Epi& E, int wave_in, const Pre pre = Pre()) {
    int lane_o; asm volatile("v_mbcnt_lo_u32_b32 %0, -1, 0\n\tv_mbcnt_hi_u32_b32 %0, -1, %0" : "=v"(lane_o));
    const int wid = __builtin_amdgcn_readfirstlane(wave_in), lane = lane_o, tid = wid * 64 + lane, wr = wid >> 2, wc = wid & 3, fr = lane & 15, fq = lane >> 4;
    const int K = g.K, nt = K / BK;
    unsigned voffA[2], voffB[2];
#pragma unroll
    for (int i = 0; i < 2; ++i) { int R, C; stage_rc(tid * 16 + i * 8192, R, C); const int Rb = Epi::PERM ? ((R & ~31) + perm32(R & 31)) : R;
        voffA[i] = (unsigned)(R * K + C) * 2u; voffB[i] = (unsigned)(Rb * K + C) * 2u; }
    const size_t kstep = (size_t)(BK * 2);
    const size_t hstep = (size_t)HALF * K * 2;
    const size_t tstep = 2 * hstep;
    const unsigned ldsw = (unsigned)wid * 1024u;
    const int aoff = lds_byte(wr * 64 + fr, fq * 8), boff = lds_byte(wc * 32 + fr, fq * 8);
#define PG8_SA(b, h) (((b) * 2 + (h)) * HTB)
#define PG8_SB(b, h) ((4 + (b) * 2 + (h)) * HTB)
#define PG8_STAGE(bufoff, gbase, voff) do { _Pragma("unroll") for (int _i = 0; _i < 2; ++_i) \
        __builtin_amdgcn_global_load_lds((const unsigned*)((const char*)(gbase) + (voff)[_i]), (PG8_LAS unsigned*)(lds + (bufoff) + ldsw + _i * 8192), 16, 0, 0); } while (0)
#define PG8_LDA(dst, b, h) do { _Pragma("unroll") for (int m = 0; m < 4; ++m) _Pragma("unroll") for (int k = 0; k < 2; ++k) dst[m][k] = *(const PG8_LAS bf16x8*)(lds + PG8_SA(b, h) + aoff + m * 2048 + k * 1024); } while (0)
#define PG8_LDB(dst, b, h) do { _Pragma("unroll") for (int n = 0; n < 2; ++n) _Pragma("unroll") for (int k = 0; k < 2; ++k) dst[n][k] = *(const PG8_LAS bf16x8*)(lds + PG8_SB(b, h) + boff + n * 2048 + k * 1024); } while (0)
#define PG8_MMA(ai, bj, At, Bt) do { __builtin_amdgcn_s_setprio(1); _Pragma("unroll") for (int m = 0; m < 4; ++m) _Pragma("unroll") for (int n = 0; n < 2; ++n) _Pragma("unroll") for (int k = 0; k < 2; ++k) \
        acc[ai][bj][m][n] = __builtin_amdgcn_mfma_f32_16x16x32_bf16(Bt[n][k], At[m][k], acc[ai][bj][m][n], 0, 0, 0); __builtin_amdgcn_s_setprio(0); } while (0)
#define PG8_WAIT_V(n) asm volatile("s_waitcnt vmcnt(" #n ")" ::: "memory")
#define PG8_WAIT_L(n) asm volatile("s_waitcnt lgkmcnt(" #n ")" ::: "memory")
#define PG8_BAR __builtin_amdgcn_s_barrier()
#define PG8_SCHED __builtin_amdgcn_sched_barrier(0)
    Unit cur, nxt; int ui = 0;
    if (!S.next(0, cur)) return;
    f32x4 acc[2][2][4][2];
#pragma unroll
    for (int a = 0; a < 2; ++a)
#pragma unroll
        for (int b = 0; b < 2; ++b)
#pragma unroll
            for (int m = 0; m < 4; ++m)
#pragma unroll
                for (int n = 0; n < 2; ++n) acc[a][b][m][n] = (f32x4){0.f, 0.f, 0.f, 0.f};
    bf16x8 At[4][2], B0[2][2], B1[2][2];
    const char* cA = (const char*)g.A + (size_t)cur.pm * tstep; const char* cB = (const char*)g.Bt + (size_t)cur.pn * tstep;
    S.a_ready(cur);
    if constexpr (SP2) {
        PG8_STAGE(PG8_SB(0, 0), cB, voffB); PG8_STAGE(PG8_SB(0, 1), cB + hstep, voffB); PG8_STAGE(PG8_SA(0, 0), cA, voffA); PG8_STAGE(PG8_SA(0, 1), cA + hstep, voffA);
        pre();
        if (wr == 1) PG8_BAR;
        PG8_WAIT_V(2); PG8_BAR;
        PG8_STAGE(PG8_SB(1, 0), cB + kstep, voffB); PG8_STAGE(PG8_SA(1, 0), cA + kstep, voffA); PG8_STAGE(PG8_SB(1, 1), cB + hstep + kstep, voffB);
        PG8_WAIT_V(6); PG8_BAR;
    } else {
        PG8_STAGE(PG8_SB(0, 0), cB, voffB); PG8_STAGE(PG8_SA(0, 0), cA, voffA); PG8_STAGE(PG8_SB(0, 1), cB + hstep, voffB); PG8_STAGE(PG8_SA(0, 1), cA + hstep, voffA);
        if (wr == 1) PG8_BAR;
        PG8_WAIT_V(4); PG8_BAR;
        PG8_STAGE(PG8_SB(1, 0), cB + kstep, voffB); PG8_STAGE(PG8_SA(1, 0), cA + kstep, voffA); PG8_STAGE(PG8_SB(1, 1), cB + hstep + kstep, voffB);
        PG8_WAIT_V(6); PG8_BAR;
    }
    for (;;) {
        const bool has_next = S.next(ui + 1, nxt);
        const char* nA = has_next ? (const char*)g.A + (size_t)nxt.pm * tstep : cA; const char* nB = has_next ? (const char*)g.Bt + (size_t)nxt.pn * tstep : cB;
        for (int t = 0; t < nt; t += 2) {
            const bool last = (t == nt - 2);
            const char* a1 = cA + (size_t)(t + 1) * kstep;
            const char* a2 = last ? nA : cA + (size_t)(t + 2) * kstep; const char* b2 = last ? nB : cB + (size_t)(t + 2) * kstep;
            const char* a3 = a2 + kstep; const char* b3 = b2 + kstep;
            if (last && has_next) S.a_ready(nxt);
            if constexpr (SP2) {
            PG8_LDB(B0, 0, 0); PG8_LDB(B1, 0, 1); PG8_SCHED; PG8_LDA(At, 0, 0); PG8_STAGE(PG8_SA(1, 1), a1 + hstep, voffA);
            PG8_WAIT_V(8); PG8_WAIT_L(0); PG8_BAR; PG8_MMA(0, 0, At, B0); PG8_MMA(0, 1, At, B1); PG8_BAR; PG8_SCHED;
            PG8_LDA(At, 0, 1); PG8_STAGE(PG8_SB(0, 0), b2, voffB); PG8_STAGE(PG8_SB(0, 1), b2 + hstep, voffB); PG8_STAGE(PG8_SA(0, 0), a2, voffA);
            PG8_WAIT_V(8); PG8_WAIT_L(0); PG8_BAR; PG8_MMA(1, 0, At, B0); PG8_MMA(1, 1, At, B1); PG8_BAR; PG8_SCHED;
            PG8_LDB(B0, 1, 0); PG8_LDB(B1, 1, 1); PG8_SCHED; PG8_LDA(At, 1, 0); PG8_STAGE(PG8_SA(0, 1), a2 + hstep, voffA);
            PG8_WAIT_V(8); PG8_WAIT_L(0); PG8_BAR; PG8_MMA(0, 0, At, B0); PG8_MMA(0, 1, At, B1); PG8_BAR; PG8_SCHED;
            PG8_LDA(At, 1, 1); PG8_STAGE(PG8_SB(1, 0), b3, voffB); PG8_STAGE(PG8_SB(1, 1), b3 + hstep, voffB); PG8_STAGE(PG8_SA(1, 0), a3, voffA);
            PG8_WAIT_V(8); PG8_WAIT_L(0); PG8_BAR; PG8_MMA(1, 0, At, B0); PG8_MMA(1, 1, At, B1); PG8_BAR; PG8_SCHED;
            } else {
            PG8_LDB(B0, 0, 0); PG8_SCHED; PG8_LDA(At, 0, 0); PG8_STAGE(PG8_SA(1, 1), a1 + hstep, voffA);
            PG8_WAIT_L(8); PG8_BAR; PG8_WAIT_L(0); PG8_MMA(0, 0, At, B0); PG8_BAR; PG8_SCHED;
            PG8_LDB(B1, 0, 1); PG8_STAGE(PG8_SB(0, 0), b2, voffB);
            PG8_BAR; PG8_WAIT_L(0); PG8_MMA(0, 1, At, B1); PG8_BAR;
            PG8_LDA(At, 0, 1); PG8_STAGE(PG8_SA(0, 0), a2, voffA);
            PG8_BAR; PG8_WAIT_L(0); PG8_MMA(1, 0, At, B0); PG8_BAR; PG8_SCHED;
            PG8_STAGE(PG8_SB(0, 1), b2 + hstep, voffB);
            PG8_WAIT_V(6); PG8_BAR; PG8_MMA(1, 1, At, B1); PG8_BAR;
            PG8_LDB(B0, 1, 0); PG8_SCHED; PG8_LDA(At, 1, 0); PG8_STAGE(PG8_SA(0, 1), a2 + hstep, voffA);
            PG8_WAIT_L(8); PG8_BAR; PG8_WAIT_L(0); PG8_MMA(0, 0, At, B0); PG8_BAR; PG8_SCHED;
            PG8_LDB(B1, 1, 1); PG8_STAGE(PG8_SB(1, 0), b3, voffB);
            PG8_BAR; PG8_WAIT_L(0); PG8_MMA(0, 1, At, B1); PG8_BAR;
            PG8_LDA(At, 1, 1); PG8_STAGE(PG8_SA(1, 0), a3, voffA);
            PG8_BAR; PG8_WAIT_L(0); PG8_MMA(1, 0, At, B0); PG8_BAR; PG8_SCHED;
            PG8_STAGE(PG8_SB(1, 1), b3 + hstep, voffB);
            PG8_WAIT_V(6); PG8_BAR; PG8_MMA(1, 1, At, B1); PG8_BAR;
            }
        }
#ifdef FK_STAMPS
        if (g.stamps && blockIdx.x == 0 && wid == 0 && lane == 0 && ui < 8) g.stamps[2 * ui] = __builtin_amdgcn_s_memrealtime();
#endif
        if constexpr (ALIGN_EPI) { if (wr == 0) PG8_BAR; }
        if constexpr (!Epi::AFTER_DRAIN) { E(acc, cur, wr, wc, fr, fq); S.done(cur); }
#ifdef FK_STAMPS
        if (g.stamps && blockIdx.x == 0 && wid == 0 && lane == 0 && ui < 8) g.stamps[2 * ui + 1] = __builtin_amdgcn_s_memrealtime();
#endif
        if (!has_next) break;
#pragma unroll
        for (int a = 0; a < 2; ++a)
#pragma unroll
            for (int b = 0; b < 2; ++b)
#pragma unroll
                for (int m = 0; m < 4; ++m)
#pragma unroll
                    for (int n = 0; n < 2; ++n) acc[a][b][m][n] = (f32x4){0.f, 0.f, 0.f, 0.f};
        cur = nxt; cA = nA; cB = nB; ++ui;
        if constexpr (ALIGN_EPI) { if (wr == 1) PG8_BAR; }
    }
    PG8_WAIT_V(0);
    if constexpr (!ALIGN_EPI) { if (wr == 0) PG8_BAR; }
    PG8_BAR;
    if constexpr (Epi::AFTER_DRAIN) { E.fused(acc, cur, wr, wc, fr, fq, lds, wid, lane); S.done(cur); }
#undef PG8_SA
#undef PG8_SB
#undef PG8_STAGE
#undef PG8_LDA
#undef PG8_LDB
#undef PG8_MMA
#undef PG8_WAIT_V
#undef PG8_WAIT_L
#undef PG8_BAR
#undef PG8_SCHED
}
}
namespace fk {
#define GAS __attribute__((address_space(1)))
#define LAS __attribute__((address_space(3)))
typedef unsigned short bf16;
typedef unsigned v4u __attribute__((ext_vector_type(4)));
typedef unsigned v2u __attribute__((ext_vector_type(2)));
typedef float f32x4 __attribute__((ext_vector_type(4)));
typedef float f32x2 __attribute__((ext_vector_type(2)));
typedef short bf16x8 __attribute__((ext_vector_type(8)));
typedef short bf16x4 __attribute__((ext_vector_type(4)));
#define LDS_WAIT() asm volatile("s_waitcnt lgkmcnt(0)" ::: "memory")
#define VM_WAIT() asm volatile("s_waitcnt vmcnt(0)" ::: "memory")
#define LBAR() do { asm volatile("s_waitcnt lgkmcnt(0)" ::: "memory"); __builtin_amdgcn_s_barrier(); asm volatile("" ::: "memory"); } while (0)

constexpr int NWAVES = 8, NTHR = 512;
constexpr int M = 16384, MS = 128, MT = M + MS, D = 1024, FF = 4096, NIN = 2056, SEQ = 2048, NB = 8;
constexpr float EPS = 1e-6f;
constexpr size_t O_YP = 0, O_YS = 16777216, O_MK = 16908288, O_MV = 21102592, O_CP = 25296896, O_NP = 26345472, O_MP = 26353664, O_CVP = 26353728,
                 O_CS = 26378304, O_NS = 43155520, O_MS = 43286592, O_CVS = 43287616, O_GV = 43680832, O_END = 43811904;
constexpr size_t MiB = 1u << 20;
constexpr size_t WS_CTL = 0, CTL_BYTES = 1 * MiB;
constexpr size_t WS_WG = 1 * MiB;
constexpr size_t WS_HW = 2 * MiB;
constexpr size_t WS_WIN = 4 * MiB, WS_WOUT = 12 * MiB, WS_WCQ = 16 * MiB, WS_WCO = 20 * MiB, WS_WUP = 24 * MiB, WS_WDOWN = 40 * MiB, WS_WMEM = 56 * MiB;
constexpr size_t WS_MB = 64 * MiB, WS_SSQM = 68 * MiB, WS_KB = 70 * MiB, WS_VTB = 78 * MiB;
constexpr size_t WS_XB = 86 * MiB, WS_X = 119 * MiB, WS_SSQ = 184 * MiB, WS_SSQV = 186 * MiB, WS_GATES = 187 * MiB, WS_BT = 188 * MiB, WS_UNITS = 189 * MiB;
constexpr size_t WS_TMP = 190 * MiB, TMP_BSTRIDE = 7340032;
constexpr size_t WS_U = WS_TMP, WS_VG = WS_TMP + 2 * MiB, WS_XM = WS_TMP + 4 * MiB, WS_OP = WS_TMP + 6 * MiB, WS_Q = WS_TMP + 8 * MiB, WS_KP = WS_TMP + 10 * MiB, WS_CONV = WS_TMP + 12 * MiB, WS_VT = WS_TMP + 14 * MiB;
constexpr size_t WS_UEXT = 318 * MiB, WS_YMIX = 354 * MiB, WS_QA = 386 * MiB, WS_ATT = WS_QA;
constexpr size_t WS_SAMP = 450 * MiB, WS_HMID = WS_TMP  , WS_FAST_END = 470 * MiB;
constexpr size_t WS_CPRE = 119 * MiB;
constexpr int CW_TMO = 0, CW_XID = 1024  , CW_LCNT = 2048  , CW_BAR = 4096;
constexpr int RING_BYTES = 131072, LDS_BYTES = 155648  , MISC_OFF = 155648 - 256;

__device__ __forceinline__ unsigned f2bf(float f) { unsigned u = __builtin_bit_cast(unsigned, f); return (u + 0x7fffu + ((u >> 16) & 1u)) >> 16; }
__device__ __forceinline__ unsigned pk2(float lo, float hi) { return f2bf(lo) | (f2bf(hi) << 16); }
typedef float f32x2_t __attribute__((ext_vector_type(2)));
typedef __bf16 bf16x2_t __attribute__((ext_vector_type(2)));
__device__ __forceinline__ unsigned cvtpk(float lo, float hi) { f32x2_t v = {lo, hi}; bf16x2_t b = __builtin_convertvector(v, bf16x2_t); return __builtin_bit_cast(unsigned, b); }
__device__ __forceinline__ int lane_id_asm() { int l; asm volatile("v_mbcnt_lo_u32_b32 %0, -1, 0\n\tv_mbcnt_hi_u32_b32 %0, -1, %0" : "=v"(l)); return l; }
__device__ __forceinline__ float bf2f(unsigned short b) { return __builtin_bit_cast(float, (unsigned)b << 16); }
__device__ __forceinline__ float wave_sum(float v) {
#pragma unroll
    for (int o = 1; o < 64; o <<= 1) v += __shfl_xor(v, o);
    return v;
}
constexpr float GELU_A = -2.302208198f, GELU_B = -0.102943240f;
__device__ __forceinline__ float gelu_f(float x) { const float z = x * __builtin_fmaf(GELU_B, x * x, GELU_A); return x * __builtin_amdgcn_rcpf(1.f + __builtin_amdgcn_exp2f(z)); }
__device__ __forceinline__ f32x4 gelu4(const f32x4 x) {
    const f32x4 z = x * (x * x * GELU_B + GELU_A); f32x4 e;
#pragma unroll
    for (int i = 0; i < 4; ++i) e[i] = __builtin_amdgcn_exp2f(z[i]);
    e = e + 1.f; f32x4 r;
#pragma unroll
    for (int i = 0; i < 4; ++i) r[i] = __builtin_amdgcn_rcpf(e[i]);
    return x * r;
}

#define XB_TMO      128
#define XB_XCNT(j)  (256  + 64 * (j))
#define XB_XSUB(j)  (1280 + 64 * (j))
#define XB_XGEN(j)  (2304 + 64 * (j))
#define XB_TOP      3328
#define XB_TOPGEN   3392
#define XCD_BAR_WORDS 3456
#define XB_SPIN_CAP (1u << 20)
__device__ __forceinline__ unsigned xb_ld(unsigned* p)              { return __hip_atomic_load(p, __ATOMIC_RELAXED, __HIP_MEMORY_SCOPE_AGENT); }
__device__ __forceinline__ unsigned xb_add(unsigned* p, unsigned v) { return __hip_atomic_fetch_add(p, v, __ATOMIC_RELAXED, __HIP_MEMORY_SCOPE_AGENT); }
__device__ __forceinline__ unsigned xb_xcc_id() { return (unsigned)__builtin_amdgcn_s_getreg((3 << 11) | 20) & 0xFu; }
#define XB_SPIN(cond, bar) do { unsigned _sp = 0; while (cond) { __builtin_amdgcn_s_sleep(1); \
    if ((++_sp & 255u) == 0u) { if (xb_ld(&(bar)[XB_TMO])) break; if (_sp > XB_SPIN_CAP) { atomicAdd(&(bar)[XB_TMO], 1u); break; } } } } while (0)
struct XcdBarrier { unsigned* bar; unsigned x; volatile LAS unsigned* st; };
__device__ __forceinline__ XcdBarrier xcd_barrier_post(unsigned* bar, volatile LAS unsigned* st) {
    XcdBarrier b; b.bar = bar; b.x = xb_xcc_id(); b.st = st;
    if (threadIdx.x == 0) (void)xb_add(&bar[XB_XCNT(b.x)], 1u);
    return b;
}
__device__ __forceinline__ void xcd_barrier_complete(unsigned* bar, unsigned x, unsigned& nloc, unsigned& nx) {
    const unsigned G = gridDim.x * gridDim.y * gridDim.z;
    unsigned sum, cnt, mine, sp = 0u;
    for (;;) {
        sum = 0u; cnt = 0u; mine = 0u;
#pragma unroll
        for (unsigned j = 0; j < 16; ++j) { const unsigned c = xb_ld(&bar[XB_XCNT(j)]); sum += c; cnt += (c > 0u) ? 1u : 0u; mine = (j == x) ? c : mine; }
        if (sum == G) break;
        __builtin_amdgcn_s_sleep(1);
        if ((++sp & 255u) == 0u) { if (xb_ld(&bar[XB_TMO])) break; if (sp > XB_SPIN_CAP) { atomicAdd(&bar[XB_TMO], 1u); break; } }
    }
    nloc = mine > 0u ? mine : 1u; nx = cnt > 0u ? cnt : 1u;
}
__device__ __forceinline__ void xcd_barrier(const XcdBarrier& b, int wave) {
    asm volatile("s_waitcnt vmcnt(0)" ::: "memory");
    __syncthreads();
    if (wave == 0 && lane_id_asm() == 0) {
        unsigned* bar = b.bar;
        __builtin_amdgcn_s_waitcnt(0);
        unsigned nloc = b.st[0], nx = b.st[1];
        if (nloc == 0u) { xcd_barrier_complete(bar, b.x, nloc, nx); b.st[0] = nloc; b.st[1] = nx; }
        const unsigned old = xb_add(&bar[XB_XSUB(b.x)], 1u);
        const unsigned gen = old / nloc;
        if (old + 1u == (gen + 1u) * nloc) {
            __builtin_amdgcn_fence(__ATOMIC_RELEASE, "agent");
            asm volatile("s_waitcnt vmcnt(0)" ::: "memory");
            const unsigned og = xb_add(&bar[XB_TOP], 1u);
            const unsigned tg = og / nx;
            if (og + 1u == (tg + 1u) * nx) xb_add(&bar[XB_TOPGEN], 1u);
            else XB_SPIN(xb_ld(&bar[XB_TOPGEN]) == tg, bar);
            __builtin_amdgcn_fence(__ATOMIC_ACQUIRE, "agent");
            xb_add(&bar[XB_XGEN(b.x)], 1u);
            asm volatile("s_waitcnt vmcnt(0)" ::: "memory");
        } else {
            XB_SPIN(xb_ld(&bar[XB_XGEN(b.x)]) == gen, bar);
            __builtin_amdgcn_fence(__ATOMIC_ACQUIRE, "agent");
            asm volatile("s_waitcnt vmcnt(0)" ::: "memory");
        }
    }
    __syncthreads();
}
__device__ __forceinline__ void xcd_local_barrier(unsigned* ctl, unsigned* bar, int xg, volatile LAS unsigned* st, int wave) {
    asm volatile("s_waitcnt vmcnt(0)" ::: "memory");
    __syncthreads();
    if (wave == 0 && lane_id_asm() == 0) {
        unsigned* c = ctl + CW_LCNT + 64 * xg;
        const unsigned k = st[3]; st[3] = k + 1u;
        (void)xb_add(c, 1u);
        __builtin_amdgcn_fence(__ATOMIC_ACQUIRE, "agent");
        const unsigned target = 32u * (k + 1u);
        XB_SPIN(xb_ld(c) < target, bar);
        asm volatile("s_waitcnt vmcnt(0)" ::: "memory");
    }
    __syncthreads();
}
}
namespace fk {
__device__ __forceinline__ void tr_item(const float* __restrict__ W, int ldw, int K, int N, bf16* WT, const float* __restrict__ gain, float alpha, LAS float* scr, int item, int lane) {
    const int nblk = N / 32, kb = item / nblk, nb = item % nblk, k0 = 64 * kb, n0 = 32 * nb;
    float wv[32];
#pragma unroll
    for (int i = 0; i < 32; ++i) wv[i] = __builtin_nontemporal_load(&W[(size_t)(k0 + 2 * i + (lane >> 5)) * ldw + n0 + (lane & 31)]);
#pragma unroll
    for (int i = 0; i < 32; ++i) { const int kk = 2 * i + (lane >> 5); const float g = gain ? gain[k0 + kk] * alpha : alpha; scr[kk * 33 + (lane & 31)] = wv[i] * g; }
    LDS_WAIT(); asm volatile("" ::: "memory");
    const int c = lane & 7;
#pragma unroll
    for (int j = 0; j < 4; ++j) { const int n = (lane >> 3) + 8 * j; const LAS float* s = scr + (8 * c) * 33 + n;
        v4u o; o.x = pk2(s[0 * 33], s[1 * 33]); o.y = pk2(s[2 * 33], s[3 * 33]); o.z = pk2(s[4 * 33], s[5 * 33]); o.w = pk2(s[6 * 33], s[7 * 33]);
        *(GAS v4u*)(WT + (size_t)(n0 + n) * K + k0 + 8 * c) = o; }
    LDS_WAIT(); asm volatile("" ::: "memory");
}
__device__ __forceinline__ float row_to_bf16(const float* xrow, bf16* orow, int lane) {
    const GAS f32x4* xr = (const GAS f32x4*)xrow + lane;
    f32x4 v[4]; float s = 0.f;
#pragma unroll
    for (int j = 0; j < 4; ++j) { v[j] = xr[64 * j]; s += (v[j].x * v[j].x + v[j].y * v[j].y) + (v[j].z * v[j].z + v[j].w * v[j].w); }
    s = wave_sum(s);
    GAS unsigned long long* o8 = (GAS unsigned long long*)orow + lane;
#pragma unroll
    for (int j = 0; j < 4; ++j) o8[64 * j] = (unsigned long long)pk2(v[j].x, v[j].y) | ((unsigned long long)pk2(v[j].z, v[j].w) << 32);
    return s;
}
struct PrepJob { const float* W; int ldw, K, N; bf16* WT; const float* gain; float alpha; int items; };
template <int PART> __device__ __forceinline__ void p0_prologue(const float* const* in, unsigned char* ws, LAS unsigned char* lds, int gw, int NGW, int wave) {
    const int lane = lane_id_asm();
    int base = 0;
    LAS float* scr = (LAS float*)(lds + wave * 16384);
    for (int l = 0; l < 2; ++l) {
        const float* g_mix = in[9] + l * 1024; const float* g_mem = in[24] + l * 1024; const float* g_xa = in[27] + l * 1024; const float* g_ffn = in[30] + l * 1024;
        PrepJob jobs[8];
        jobs[0] = PrepJob{in[10] + (size_t)l * 1024 * NIN, NIN, 1024, 2048, (bf16*)(ws + WS_WIN) + (size_t)l * 2048 * 1024, g_mix, 1.f, 0};
        jobs[1] = PrepJob{in[23] + (size_t)l * 1048576, 1024, 1024, 1024, (bf16*)(ws + WS_WOUT) + (size_t)l * 1048576, nullptr, 1.f, 0};
        jobs[2] = PrepJob{in[28] + (size_t)l * 1048576, 1024, 1024, 1024, (bf16*)(ws + WS_WCQ) + (size_t)l * 1048576, g_xa, 0.0625f, 0};
        jobs[3] = PrepJob{in[29] + (size_t)l * 1048576, 1024, 1024, 1024, (bf16*)(ws + WS_WCO) + (size_t)l * 1048576, nullptr, 1.f, 0};
        jobs[4] = PrepJob{in[31] + (size_t)l * 4194304, 4096, 1024, 4096, (bf16*)(ws + WS_WUP) + (size_t)l * 4194304, g_ffn, 1.f, 0};
        jobs[5] = PrepJob{in[32] + (size_t)l * 4194304, 1024, 4096, 1024, (bf16*)(ws + WS_WDOWN) + (size_t)l * 4194304, nullptr, 1.f, 0};
        jobs[6] = PrepJob{in[25] + (size_t)l * 1048576, 1024, 1024, 1024, (bf16*)(ws + WS_WMEM) + (size_t)l * 2097152, g_mem, 1.f, 0};
        jobs[7] = PrepJob{in[26] + (size_t)l * 1048576, 1024, 1024, 1024, (bf16*)(ws + WS_WMEM) + (size_t)l * 2097152 + 1048576, g_mem, 1.f, 0};
#pragma unroll
        for (int j = 0; j < 8; ++j) {
            const bool early = (j == 0 && l == 0) || j >= 6;
            if (early != (PART == 0)) continue;
            const int items = (jobs[j].K / 64) * (jobs[j].N / 32);
            { int first = gw - (base % NGW); if (first < 0) first += NGW;
              for (int it = first; it < items; it += NGW) tr_item(jobs[j].W, jobs[j].ldw, jobs[j].K, jobs[j].N, jobs[j].WT, jobs[j].gain, jobs[j].alpha, scr, it, lane);
              base += items; }
        }
        if (PART == 1) continue;
        int firsth = gw - (base % NGW); if (firsth < 0) firsth += NGW; base += 96;
        for (int it = firsth; it < 96; it += NGW) { const int mat = it >> 3, sub = it & 7, which = mat >> 2, h = mat & 3;
            const float* W = in[16 + which] + (size_t)l * 65536 + (size_t)h * 16384;
            bf16* WT = (bf16*)(ws + WS_HW) + ((size_t)(l * 3 + which) * 4 + h) * 16384;
            tr_item(W, 128, 128, 128, WT, nullptr, which == 1 ? 0.08838834764831845f : 1.f, scr, sub, lane); }
        for (int i = gw * 64 + lane; i < 16384; i += NGW * 64) { const int c = i >> 10, k = i & 1023;
            ((bf16*)(ws + WS_WG + 65536))[l * 16384 + i] = c < 8 ? (bf16)f2bf(in[10][(size_t)l * 1024 * NIN + (size_t)k * NIN + 2048 + c] * g_mix[k]) : (bf16)0; }
        for (int i = gw * 64 + lane; i < 8192; i += NGW * 64) { const int c = i >> 10, k = i & 1023;
            ((float*)(ws + WS_WG))[l * 8192 + i] = in[10][(size_t)l * 1024 * NIN + (size_t)k * NIN + 2048 + c] * g_mix[k]; }
    }
    if (PART == 1) return;
    bf16* XB = (bf16*)(ws + WS_XB); float* SSQ = (float*)(ws + WS_SSQ);
    for (int r = gw; r < MT; r += 4 * NGW) {
        int rr[4]; f32x4 v[4][4];
#pragma unroll
        for (int k = 0; k < 4; ++k) { rr[k] = (r + k * NGW < MT) ? r + k * NGW : r;
            const float* src = rr[k] < M ? in[0] + (size_t)rr[k] * D : in[1] + (size_t)(rr[k] - M) * D; const GAS f32x4* xp = (const GAS f32x4*)src + lane;
#pragma unroll
            for (int j = 0; j < 4; ++j) v[k][j] = __builtin_nontemporal_load((const f32x4*)(src) + lane + 64 * j); }
        asm volatile("" ::: "memory");
#pragma unroll
        for (int k = 0; k < 4; ++k) { if (k > 0 && rr[k] == r) continue;
            float sa = 0.f;
#pragma unroll
            for (int j = 0; j < 4; ++j) sa += (v[k][j].x * v[k][j].x + v[k][j].y * v[k][j].y) + (v[k][j].z * v[k][j].z + v[k][j].w * v[k][j].w);
            sa = wave_sum(sa);
            GAS unsigned long long* oa = (GAS unsigned long long*)(XB + (size_t)rr[k] * D) + lane;
#pragma unroll
            for (int j = 0; j < 4; ++j) oa[64 * j] = (unsigned long long)pk2(v[k][j].x, v[k][j].y) | ((unsigned long long)pk2(v[k][j].z, v[k][j].w) << 32);
            if (lane < 16) SSQ[(size_t)rr[k] * 16 + lane] = lane == 0 ? sa : 0.f; }
    }
    for (int r = gw; r < 2048; r += NGW) {
        const float s = row_to_bf16(in[2] + (size_t)r * D, (bf16*)(ws + WS_MB) + (size_t)r * D, lane);
        if (lane == 0) ((float*)(ws + WS_SSQM))[r] = s;
    }
}
}
namespace fk {
using pg8::Unit;
__device__ __forceinline__ float rstd16(const float* SSQ, int row) {
    const f32x4* p = (const f32x4*)(SSQ + (size_t)row * 16); const f32x4 a = p[0], b = p[1], c = p[2], d = p[3];
    const float s = ((a.x + a.y) + (a.z + a.w)) + ((b.x + b.y) + (b.z + b.w)) + ((c.x + c.y) + (c.z + c.w)) + ((d.x + d.y) + (d.z + d.w));
    return rsqrtf(s * (1.f / 1024.f) + EPS);
}
constexpr int RT_OFF = RING_BYTES;
template <class Sched> __device__ __forceinline__ void rstd_table_fill(LAS unsigned char* lds, const Sched& S, const float* SSQ, int wave) {
    const int tid = wave * 64 + lane_id_asm(); LAS float* tab = (LAS float*)(lds + RT_OFF); LAS int* dir = (LAS int*)(lds + RT_OFF + 4096);
    Unit u;
#pragma unroll
    for (int j = 0; j < 2; ++j) { const int i = 2 * j + (tid >> 8);
        if (S.next(i, u)) { tab[i * 256 + (tid & 255)] = rstd16(SSQ, u.pm * 256 + (tid & 255)); if ((tid & 255) == 0) dir[i] = u.pm; }
        else if ((tid & 255) == 0) dir[i] = -1; }
    LBAR();
}
__device__ __forceinline__ const LAS float* rstd_table_rows(LAS unsigned char* lds, int pm) {
    const LAS int* dir = (const LAS int*)(lds + RT_OFF + 4096); int slot = 0;
#pragma unroll
    for (int q = 1; q < 4; ++q) if (dir[q] == pm) slot = q;
    if (dir[0] == pm) slot = 0;
    return (const LAS float*)(lds + RT_OFF) + slot * 256;
}
__device__ __forceinline__ v4u pack8(const f32x4 a, const f32x4 b) { v4u w; w.x = cvtpk(a[0], a[1]); w.y = cvtpk(a[2], a[3]); w.z = cvtpk(b[0], b[1]); w.w = cvtpk(b[2], b[3]); return w; }

struct EpiMemKV {
    static constexpr bool PERM = false, AFTER_DRAIN = false;
    float* out; bf16* KB; bf16* VTB; const float* SSQM;
    __device__ __forceinline__ void operator()(const f32x4 (&acc)[2][2][4][2], const Unit& u, int wr, int wc, int fr, int fq) const {
        const int l = u.pn >> 3, isv = (u.pn >> 2) & 1, colt = (u.pn & 3) * 256 + wc * 32 + 4 * fq;
        float* o32 = out + (isv ? O_MV : O_MK) + (size_t)l * 2097152;
#pragma unroll
        for (int ai = 0; ai < 2; ++ai)
#pragma unroll
            for (int m = 0; m < 4; ++m) { const int row = u.pm * 256 + ai * 128 + wr * 64 + m * 16 + fr;
                const float rs = rsqrtf(SSQM[row] * (1.f / 1024.f) + EPS);
#pragma unroll
                for (int bj = 0; bj < 2; ++bj)
#pragma unroll
                    for (int n = 0; n < 2; ++n) { const int col = colt + bj * 128 + n * 16; const f32x4 v = acc[ai][bj][m][n] * rs;
                        *(f32x4*)(o32 + (size_t)row * 1024 + col) = v;
                        if (!isv) { v2u w; w.x = cvtpk(v[0], v[1]); w.y = cvtpk(v[2], v[3]); *(v2u*)(KB + (size_t)l * 2097152 + (size_t)row * 1024 + col) = w; }
                        else { const int b = row >> 8, mm = row & 255;
#pragma unroll
                            for (int e = 0; e < 4; ++e) { const int c = col + e, h = c >> 8, d = c & 255;
                                VTB[(((size_t)(l * 32 + b * 4 + h)) * 256 + d) * 256 + mm] = (bf16)f2bf(v[e]); } } } }
    }
};
struct EpiG1 {
    static constexpr bool PERM = true, AFTER_DRAIN = false;
    bf16 *U, *VG, *XM, *OP; LAS unsigned char* lds; float* SSQV; float* convout;
    __device__ __forceinline__ void operator()(const f32x4 (&acc)[2][2][4][2], const Unit& u, int wr, int wc, int fr, int fq) const {
        const int t = u.pn >> 1; bf16* base = (t == 0 ? U : (t == 1 ? VG : (t == 2 ? XM : OP))) + (size_t)(u.pm >> 3) * TMP_BSTRIDE;
        const int colb = (u.pn & 1) * 256 + wc * 32 + 8 * fq; const LAS float* rt = rstd_table_rows(lds, u.pm);
#pragma unroll
        for (int ai = 0; ai < 2; ++ai)
#pragma unroll
            for (int m = 0; m < 4; ++m) { const int rl = ai * 128 + wr * 64 + m * 16 + fr, row = u.pm * 256 + rl;
                const float rs = rt[rl]; float ss = 0.f;
#pragma unroll
                for (int bj = 0; bj < 2; ++bj) { f32x4 v0 = acc[ai][bj][m][0] * rs, v1 = acc[ai][bj][m][1] * rs;
                    if (t < 2) { v0 = gelu4(v0); v1 = gelu4(v1);
                        if (t == 1) ss += ((v0[0] * v0[0] + v0[1] * v0[1]) + (v0[2] * v0[2] + v0[3] * v0[3])) + ((v1[0] * v1[0] + v1[1] * v1[1]) + (v1[2] * v1[2] + v1[3] * v1[3])); }
                    *(v4u*)(base + (size_t)row * 512 + colb + bj * 128) = pack8(v0, v1);
                    if (t == 2 && (row & 2047) >= 2045) { float* cp = convout + (size_t)(row >> 11) * 1536 + (size_t)((row & 2047) - 2045) * 512 + colb + bj * 128;
                        *(f32x4*)cp = v0; *(f32x4*)(cp + 4) = v1; } }
                if (t == 1) { ss += __shfl_xor(ss, 16); ss += __shfl_xor(ss, 32); if (fq == 0) SSQV[(size_t)row * 8 + (u.pn & 1) * 4 + wc] = ss; }
                __builtin_amdgcn_sched_barrier(0); }
    }
};
struct EpiResid {
    static constexpr bool PERM = true, AFTER_DRAIN = false;
    bf16* XB; float* SSQ;
    __device__ __forceinline__ void operator()(const f32x4 (&acc)[2][2][4][2], const Unit& u, int wr, int wc, int fr, int fq) const {
        const int colb = u.pn * 256 + wc * 32 + 8 * fq;
#pragma unroll
        for (int ai = 0; ai < 2; ++ai) {
            v4u xo[4][2];
#pragma unroll
            for (int m = 0; m < 4; ++m) { const size_t row = (size_t)(u.pm * 256 + ai * 128 + wr * 64 + m * 16 + fr);
#pragma unroll
                for (int bj = 0; bj < 2; ++bj) xo[m][bj] = *(const v4u*)(XB + row * 1024 + colb + bj * 128); }
            asm volatile("" ::: "memory");
#pragma unroll
            for (int m = 0; m < 4; ++m) { const size_t row = (size_t)(u.pm * 256 + ai * 128 + wr * 64 + m * 16 + fr); float ss = 0.f;
#pragma unroll
                for (int bj = 0; bj < 2; ++bj) { f32x4 v0 = acc[ai][bj][m][0], v1 = acc[ai][bj][m][1]; const v4u x = xo[m][bj];
                    v0[0] += __builtin_bit_cast(float, x[0] << 16); v0[1] += __builtin_bit_cast(float, x[0] & 0xffff0000u); v0[2] += __builtin_bit_cast(float, x[1] << 16); v0[3] += __builtin_bit_cast(float, x[1] & 0xffff0000u);
                    v1[0] += __builtin_bit_cast(float, x[2] << 16); v1[1] += __builtin_bit_cast(float, x[2] & 0xffff0000u); v1[2] += __builtin_bit_cast(float, x[3] << 16); v1[3] += __builtin_bit_cast(float, x[3] & 0xffff0000u);
                    *(v4u*)(XB + row * 1024 + colb + bj * 128) = pack8(v0, v1);
                    ss += ((v0[0] * v0[0] + v0[1] * v0[1]) + (v0[2] * v0[2] + v0[3] * v0[3])) + ((v1[0] * v1[0] + v1[1] * v1[1]) + (v1[2] * v1[2] + v1[3] * v1[3])); }
                ss += __shfl_xor(ss, 16); ss += __shfl_xor(ss, 32); if (fq == 0) SSQ[row * 16 + u.pn * 4 + wc] = ss; }
            asm volatile("" ::: "memory"); }
    }
};
template <int ACT> struct EpiScaleBf16 {
    static constexpr bool PERM = true, AFTER_DRAIN = false;
    bf16* O; int ldo; LAS unsigned char* lds;
    __device__ __forceinline__ void operator()(const f32x4 (&acc)[2][2][4][2], const Unit& u, int wr, int wc, int fr, int fq) const {
        const int colb = u.pn * 256 + wc * 32 + 8 * fq; const LAS float* rt = rstd_table_rows(lds, u.pm);
#pragma unroll
        for (int ai = 0; ai < 2; ++ai)
#pragma unroll
            for (int m = 0; m < 4; ++m) { const int rl = ai * 128 + wr * 64 + m * 16 + fr, row = u.pm * 256 + rl; const float rs = rt[rl];
#pragma unroll
                for (int bj = 0; bj < 2; ++bj) { f32x4 v0 = acc[ai][bj][m][0] * rs, v1 = acc[ai][bj][m][1] * rs;
                    if (ACT == 1) {
#pragma unroll
                        for (int e = 0; e < 4; ++e) { const float a = fmaxf(v0[e], 0.f), b = fmaxf(v1[e], 0.f); v0[e] = a * a; v1[e] = b * b; } }
                    *(v4u*)(O + (size_t)row * ldo + colb + bj * 128) = pack8(v0, v1); }
                __builtin_amdgcn_sched_barrier(0); }
    }
};
}
namespace fk {
typedef float f32x4m __attribute__((ext_vector_type(4)));
#define MFMA16(a, b, c) __builtin_amdgcn_mfma_f32_16x16x32_bf16((a), (b), (c), 0, 0, 0)
constexpr int IMG_LD = 136;
constexpr int IMG128 = 128 * IMG_LD * 2;
constexpr int IMG144 = 144 * IMG_LD * 2;
__device__ __forceinline__ bf16x8 lds_frag(LAS unsigned char* lds, int img, int row, int k) { return *(const LAS bf16x8*)(lds + img + row * (IMG_LD * 2) + k * 2); }
__device__ __forceinline__ v2u pack4(float a, float b, float c, float d) { v2u w; w.x = cvtpk(a, b); w.y = cvtpk(c, d); return w; }
__device__ __forceinline__ float sigmoid_f(float x) { return __builtin_amdgcn_rcpf(1.f + __expf(-x)); }
#ifdef FK_STAMPS
#define USTAMP(k) do { if (l == 0 && b == 0 && h == 0 && jj == 0 && wave == 0 && lane == 0) ((unsigned long long*)(ws + WS_CTL + 32768 * 4))[k] = __builtin_amdgcn_s_memrealtime(); } while (0)
#else
#define USTAMP(k) do { } while (0)
#endif
__device__ __forceinline__ int opaque(int x) { asm volatile("" : "+v"(x)); return x; }

__device__ __forceinline__ void gate_prelude_mfma(unsigned char* ws, LAS unsigned char* lds, int l, int gw_, int wave) {
    const int lane = lane_id_asm(), tid = wave * 64 + lane, fr = lane & 15, g = lane >> 4; int gw = gw_; asm volatile("" : "+s"(gw));
    constexpr int WLD = 1032;
    const bf16* WGB = (const bf16*)(ws + WS_WG + 65536) + l * 16384; const bf16* XB = (const bf16*)(ws + WS_XB); const float* SSQ = (const float*)(ws + WS_SSQ); float* GATES = (float*)(ws + WS_GATES);
    v4u wreg[4];
#pragma unroll
    for (int it = 0; it < 4; ++it) { const int ch = tid + it * NTHR; wreg[it] = *(const v4u*)(WGB + (size_t)ch * 8); }
    const bool active = gw < MT / 16; const int r0 = active ? 16 * gw : 0;
    bf16x8 af[32];
#pragma unroll
    for (int st = 0; st < 32; ++st) af[st] = *(const bf16x8*)(XB + (size_t)(r0 + fr) * D + 32 * st + 8 * g);
    asm volatile("" ::: "memory");
    LBAR();
#pragma unroll
    for (int it = 0; it < 4; ++it) { const int ch = tid + it * NTHR, row = ch >> 7, c16 = ch & 127; *(LAS v4u*)(lds + row * (WLD * 2) + c16 * 16) = wreg[it]; }
    LBAR();
    float ssq = 0.f;
#pragma unroll
    for (int st = 0; st < 32; ++st) { const v4u w = __builtin_bit_cast(v4u, af[st]);
#pragma unroll
        for (int e = 0; e < 4; ++e) { const float lo = __builtin_bit_cast(float, w[e] << 16), hi = __builtin_bit_cast(float, w[e] & 0xffff0000u); ssq += lo * lo + hi * hi; } }
    ssq += __shfl_xor(ssq, 16); ssq += __shfl_xor(ssq, 32);
    const float rsrow = rsqrtf(ssq * (1.f / 1024.f) + EPS);
    f32x4 acc = (f32x4){0.f, 0.f, 0.f, 0.f};
#pragma unroll
    for (int st = 0; st < 32; ++st) acc = MFMA16(af[st], *(const LAS bf16x8*)(lds + fr * (WLD * 2) + (32 * st + 8 * g) * 2), acc);
#pragma unroll
    for (int r = 0; r < 4; ++r) { const float rs = __shfl(rsrow, 4 * g + r);
        if (active && fr < 8) GATES[(size_t)(r0 + 4 * g + r) * 8 + fr] = acc[r] * rs; }
    LBAR();
}

__device__ __forceinline__ void mlstm_local_unit(const float* const* in, unsigned char* ws, LAS unsigned char* lds, int l, int b, int h, int jj, int wave) {
    const int lane = lane_id_asm(), tid = wave * 64 + lane;
    constexpr int O_WK = 0, O_WV = IMG128, O_KT = 2 * IMG128, O_VT = 3 * IMG128, O_SC = 3 * IMG128 + IMG144;
    LAS float* sS = (LAS float*)(lds + O_SC); LAS float* sG = sS + 128; LAS float* sR = sG + 128;
    const int r0 = b * SEQ + 128 * jj, unit = (b * 4 + h) * 16 + jj;
    const float* GATES = (const float*)(ws + WS_GATES); float* BT = (float*)(ws + WS_BT); float* UNITS = (float*)(ws + WS_UNITS);
    const size_t bo = (size_t)b * TMP_BSTRIDE;
    const bf16* XM = (const bf16*)(ws + WS_XM) + bo; bf16* CONV = (bf16*)(ws + WS_CONV) + bo; bf16* Q = (bf16*)(ws + WS_Q) + bo; bf16* KP = (bf16*)(ws + WS_KP) + bo; bf16* VT = (bf16*)(ws + WS_VT) + bo;
    const bf16* HW = (const bf16*)(ws + WS_HW) + (size_t)l * 3 * 4 * 16384;
    const bf16* wqT = HW + (size_t)(0 * 4 + h) * 16384; const bf16* wkT = HW + (size_t)(1 * 4 + h) * 16384; const bf16* wvT = HW + (size_t)(2 * 4 + h) * 16384;
    USTAMP(50);
    const int fr = lane & 15, g = lane >> 4, t = 16 * wave + fr, pos = 128 * jj + t;
    float gi = 0.f, gf = 0.f;
    if (tid < 128) { gi = GATES[(size_t)(r0 + tid) * 8 + h]; gf = GATES[(size_t)(r0 + tid) * 8 + 4 + h]; }
    v4u xall[4][4];
#pragma unroll
    for (int st = 0; st < 4; ++st)
#pragma unroll
        for (int i = 0; i < 4; ++i) { const int dr = (pos - 3 + i >= 0) ? (t - 3 + i) : t;
            xall[st][i] = *(const v4u*)(XM + (size_t)(r0 + dr) * 512 + h * 128 + 32 * st + 8 * g); }
#pragma unroll
    for (int st = 0; st < 4; ++st)
#pragma unroll
        for (int i = 0; i < 3; ++i) if (pos - 3 + i < 0) xall[st][i] = (v4u){0u, 0u, 0u, 0u};
    v4u sreg[8];
#pragma unroll
    for (int it = 0; it < 8; ++it) { const int ch = tid + it * NTHR, which = ch >> 11, rem = ch & 2047, row = rem >> 4, c16 = rem & 15; sreg[it] = *(const v4u*)((which ? wvT : wkT) + row * 128 + c16 * 8); }
    f32x4 cwv = (f32x4){0.f, 0.f, 0.f, 0.f};
    if (tid < 160) { const int rw = tid >> 5, c4 = (tid & 31) * 4; cwv = rw < 4 ? *(const f32x4*)(in[14] + (size_t)l * 2048 + rw * 512 + h * 128 + c4) : *(const f32x4*)(in[15] + (size_t)l * 512 + h * 128 + c4); }
    LAS float* sCW = sR + 8;
    LBAR();
    USTAMP(51);
#pragma unroll
    for (int it = 0; it < 8; ++it) { const int ch = tid + it * NTHR, which = ch >> 11, rem = ch & 2047, row = rem >> 4, c16 = rem & 15;
        *(LAS v4u*)(lds + (which ? O_WV : O_WK) + row * (IMG_LD * 2) + c16 * 16) = sreg[it]; }
    if (tid < 160) *(LAS f32x4*)(sCW + 4 * tid) = cwv;
    for (int i = tid; i < 16 * IMG_LD / 2; i += NTHR) { const int row = i / (IMG_LD / 2); ((LAS unsigned*)(lds + O_VT + 128 * IMG_LD * 2))[i] = row == 0 ? 0x3f803f80u : 0u; }
    USTAMP(52);
    float ig = 0.f, bt = 0.f;
    if (tid < 128) { ig = gi + in[19][l * 4 + h]; const float z = gf + in[20][l * 4 + h];
        bt = fminf(z, 0.f) - __logf(1.f + __expf(-fabsf(z)));
#pragma unroll
        for (int o = 1; o < 64; o <<= 1) { const float up = __shfl_up(bt, o); if (lane >= o) bt += up; }
        if (tid == 63) sS[0] = bt; }
    LBAR();
    if (tid >= 64 && tid < 128) bt += sS[0];
    float gt = ig - bt;
    if (tid < 128) { float mx = gt;
#pragma unroll
        for (int o = 32; o > 0; o >>= 1) mx = fmaxf(mx, __shfl_xor(mx, o));
        if (lane == 0) sR[wave] = mx; }
    LBAR();
    USTAMP(53);
    const float cmax = fmaxf(sR[0], sR[1]);
    if (tid < 128) { sG[tid] = __expf(gt - cmax); BT[(size_t)(r0 + tid) * 4 + h] = bt; if (tid == 127) { UNITS[unit * 4 + 0] = cmax; UNITS[unit * 4 + 1] = bt; } }
    bf16x8 CA[4], XF[4];
#pragma unroll
    for (int st = 0; st < 4; ++st) { const int c0 = 32 * st + 8 * g;
        float a[8];
        { const f32x4 b0 = *(const LAS f32x4*)(sCW + 512 + c0), b1 = *(const LAS f32x4*)(sCW + 512 + c0 + 4);
#pragma unroll
          for (int e = 0; e < 4; ++e) { a[e] = b0[e]; a[4 + e] = b1[e]; } }
#pragma unroll
        for (int i = 0; i < 4; ++i) { const v4u xv = xall[st][i];
            const f32x4 w0 = *(const LAS f32x4*)(sCW + i * 128 + c0), w1 = *(const LAS f32x4*)(sCW + i * 128 + c0 + 4);
#pragma unroll
            for (int e = 0; e < 4; ++e) { const float lo = __builtin_bit_cast(float, xv[e] << 16), hi = __builtin_bit_cast(float, xv[e] & 0xffff0000u);
                a[2 * e] += lo * (e < 2 ? w0[2 * e] : w1[2 * e - 4]); a[2 * e + 1] += hi * (e < 2 ? w0[2 * e + 1] : w1[2 * e - 3]); }
            if (i == 3) XF[st] = __builtin_bit_cast(bf16x8, xv); }
#pragma unroll
        for (int e = 0; e < 8; ++e) a[e] = a[e] * sigmoid_f(a[e]);
        const v4u cv = (v4u){cvtpk(a[0], a[1]), cvtpk(a[2], a[3]), cvtpk(a[4], a[5]), cvtpk(a[6], a[7])};
        CA[st] = __builtin_bit_cast(bf16x8, cv);
        *(v4u*)(CONV + (size_t)(r0 + t) * 512 + h * 128 + c0) = cv; }
    bf16x8 wqf[8][4];
#pragma unroll
    for (int it = 0; it < 8; ++it)
#pragma unroll
        for (int st = 0; st < 4; ++st) wqf[it][st] = *(const bf16x8*)(wqT + (16 * it + fr) * 128 + 32 * st + 8 * g);
    USTAMP(54);
    LBAR();
    USTAMP(55);
    const float sgY = sG[t];
    f32x4 sgX; sgX[0] = sG[16 * wave + 4 * g]; sgX[1] = sG[16 * wave + 4 * g + 1]; sgX[2] = sG[16 * wave + 4 * g + 2]; sgX[3] = sG[16 * wave + 4 * g + 3];
#pragma unroll
    for (int it = 0; it < 8; ++it) {
        f32x4 ak = (f32x4){0.f, 0.f, 0.f, 0.f}, akx = ak, avx = ak;
#pragma unroll
        for (int st = 0; st < 4; ++st) {
            const bf16x8 wk = lds_frag(lds, O_WK, 16 * it + fr, 32 * st + 8 * g), wv = lds_frag(lds, O_WV, 16 * it + fr, 32 * st + 8 * g);
            ak = MFMA16(wk, CA[st], ak); akx = MFMA16(CA[st], wk, akx); avx = MFMA16(XF[st], wv, avx);
        }
        *(v2u*)(KP + (size_t)(r0 + t) * 512 + h * 128 + 16 * it + 4 * g) = pack4(ak[0] * sgY, ak[1] * sgY, ak[2] * sgY, ak[3] * sgY);
        *(LAS v2u*)(lds + O_KT + (16 * it + fr) * (IMG_LD * 2) + (16 * wave + 4 * g) * 2) = pack4(akx[0] * sgX[0], akx[1] * sgX[1], akx[2] * sgX[2], akx[3] * sgX[3]);
        const v2u vv = pack4(avx[0], avx[1], avx[2], avx[3]);
        *(LAS v2u*)(lds + O_VT + (16 * it + fr) * (IMG_LD * 2) + (16 * wave + 4 * g) * 2) = vv;
        *(v2u*)(VT + ((size_t)(b * 4 + h) * 128 + 16 * it + fr) * SEQ + 128 * jj + 16 * wave + 4 * g) = vv;
        __builtin_amdgcn_sched_barrier(0);
    }
    USTAMP(56);
    LBAR();
    USTAMP(57);
    bf16* UE = (bf16*)(ws + WS_UEXT) + (size_t)unit * 144 * 128;
    bf16x8 kf[4];
#pragma unroll
    for (int st = 0; st < 4; ++st) kf[st] = lds_frag(lds, O_KT, 16 * wave + fr, 32 * st + 8 * g);
#pragma unroll 3
    for (int dt = 0; dt < 9; ++dt) { f32x4 au = (f32x4){0.f, 0.f, 0.f, 0.f};
#pragma unroll
        for (int st = 0; st < 4; ++st) au = MFMA16(kf[st], lds_frag(lds, O_VT, 16 * dt + fr, 32 * st + 8 * g), au);
        *(v2u*)(UE + (size_t)(16 * dt + fr) * 128 + 16 * wave + 4 * g) = pack4(au[0], au[1], au[2], au[3]); }
    __builtin_amdgcn_sched_barrier(0);
#pragma unroll
    for (int it = 0; it < 8; ++it) { f32x4 aq = (f32x4){0.f, 0.f, 0.f, 0.f};
#pragma unroll
        for (int st = 0; st < 4; ++st) aq = MFMA16(wqf[it][st], CA[st], aq);
        *(v2u*)(Q + (size_t)(r0 + t) * 512 + h * 128 + 16 * it + 4 * g) = pack4(aq[0], aq[1], aq[2], aq[3]); }
    USTAMP(58);
}

__device__ __forceinline__ void gmlp_unit(const float* const* in, unsigned char* ws, LAS unsigned char* lds, int l, int b, int n, int h, int wave) {
    const int lane = lane_id_asm(), tid = wave * 64 + lane;
    constexpr int O_WS = 0, O_VG = IMG128, O_RS = 2 * IMG128;
    LAS float* sRS = (LAS float*)(lds + O_RS);
    const int r0 = b * SEQ + 128 * n;
    const bf16* VG = (const bf16*)(ws + WS_VG); const bf16* U = (const bf16*)(ws + WS_U); bf16* YMIX = (bf16*)(ws + WS_YMIX); const float* SSQV = (const float*)(ws + WS_SSQV);
    const float* wsp = in[12] + (size_t)l * 65536 + (size_t)h * 16384; const float* bsp = in[13] + (size_t)l * 512 + h * 128; const float* gvg = in[11] + (size_t)l * 512 + h * 128;
    f32x4 sa = (f32x4){0.f, 0.f, 0.f, 0.f}, sb = sa;
    if (tid < 128) { sa = *(const f32x4*)(SSQV + (size_t)(r0 + tid) * 8); sb = *(const f32x4*)(SSQV + (size_t)(r0 + tid) * 8 + 4); }
    f32x4 wreg[8]; v4u vreg[4];
#pragma unroll
    for (int it = 0; it < 8; ++it) { const int ch = tid + it * NTHR, tt = ch >> 5, s0 = (ch & 31) * 4; wreg[it] = *(const f32x4*)(wsp + tt * 128 + s0); }
#pragma unroll
    for (int it = 0; it < 4; ++it) { const int ch = tid + it * NTHR, sidx = ch & 127, d0 = (ch >> 7) * 8; vreg[it] = *(const v4u*)(VG + (size_t)b * TMP_BSTRIDE + (size_t)(r0 + sidx) * 512 + h * 128 + d0); }
    const int fr = lane & 15, g = lane >> 4, t = 16 * wave + fr, nst = (16 * wave + 15) / 32 + 1;
    v2u uur[8]; f32x4 gvr[8];
#pragma unroll
    for (int dt = 0; dt < 8; ++dt) { uur[dt] = *(const v2u*)(U + (size_t)b * TMP_BSTRIDE + (size_t)(r0 + t) * 512 + h * 128 + 16 * dt + 4 * g); gvr[dt] = *(const f32x4*)(gvg + 16 * dt + 4 * g); }
    const float bsv = bsp[t];
    asm volatile("" ::: "memory");
    LBAR();
    if (tid < 128) sRS[tid] = rsqrtf((((sa[0] + sa[1]) + (sa[2] + sa[3])) + ((sb[0] + sb[1]) + (sb[2] + sb[3]))) * (1.f / 512.f) + EPS);
#pragma unroll
    for (int it = 0; it < 4; ++it) { const int ch = tid + it * NTHR, sidx = ch & 127, d0 = (ch >> 7) * 8; const v4u v = vreg[it];
#pragma unroll
        for (int e = 0; e < 4; ++e) { *(LAS unsigned short*)(lds + O_VG + (d0 + 2 * e) * (IMG_LD * 2) + sidx * 2) = (unsigned short)(v[e] & 0xffffu);
                                       *(LAS unsigned short*)(lds + O_VG + (d0 + 2 * e + 1) * (IMG_LD * 2) + sidx * 2) = (unsigned short)(v[e] >> 16); } }
    LBAR();
#pragma unroll
    for (int it = 0; it < 8; ++it) { const int ch = tid + it * NTHR, tt = ch >> 5, s0 = (ch & 31) * 4; const f32x4 w = wreg[it];
        float v[4];
#pragma unroll
        for (int e = 0; e < 4; ++e) v[e] = (s0 + e <= tt) ? w[e] * sRS[s0 + e] : 0.f;
        *(LAS v2u*)(lds + O_WS + tt * (IMG_LD * 2) + s0 * 2) = pack4(v[0], v[1], v[2], v[3]); }
    LBAR();
    bf16x8 wf[4];
#pragma unroll
    for (int st = 0; st < 4; ++st) wf[st] = lds_frag(lds, O_WS, t, 32 * st + 8 * g);
#pragma unroll
    for (int dt = 0; dt < 8; ++dt) { f32x4 am = (f32x4){0.f, 0.f, 0.f, 0.f};
#pragma unroll
        for (int st = 0; st < 4; ++st) if (st < nst) am = MFMA16(lds_frag(lds, O_VG, 16 * dt + fr, 32 * st + 8 * g), wf[st], am);
        const int d0 = 16 * dt + 4 * g; const f32x4 gv = gvr[dt]; const v2u uu = uur[dt];
        const float u0 = __builtin_bit_cast(float, uu[0] << 16), u1 = __builtin_bit_cast(float, uu[0] & 0xffff0000u), u2 = __builtin_bit_cast(float, uu[1] << 16), u3 = __builtin_bit_cast(float, uu[1] & 0xffff0000u);
        *(v2u*)(YMIX + (size_t)(r0 + t) * 1024 + h * 128 + d0) = pack4(u0 * (am[0] * gv[0] + bsv), u1 * (am[1] * gv[1] + bsv), u2 * (am[2] * gv[2] + bsv), u3 * (am[3] * gv[3] + bsv)); }
}

__device__ __forceinline__ void gmlp_pair(const float* const* in, unsigned char* ws, LAS unsigned char* lds, int l, int bA, int bB, int nA, int nB, int h, int wave) {
    const int lane = lane_id_asm(), tid = wave * 64 + lane;
    constexpr int LQ = 2 * IMG128 + 1024;
    constexpr int O_WS = 0, O_VG = IMG128, O_RS = 2 * IMG128;
    const bf16* VG = (const bf16*)(ws + WS_VG); const bf16* U = (const bf16*)(ws + WS_U); bf16* YMIX = (bf16*)(ws + WS_YMIX); const float* SSQV = (const float*)(ws + WS_SSQV);
    const float* wsp = in[12] + (size_t)l * 65536 + (size_t)h * 16384; const float* bsp = in[13] + (size_t)l * 512 + h * 128; const float* gvg = in[11] + (size_t)l * 512 + h * 128;
    const int fr = lane & 15, g = lane >> 4, t = 16 * wave + fr, nst = (16 * wave + 15) / 32 + 1;
    int r0[2]; r0[0] = bA * SEQ + 128 * nA; r0[1] = bB * SEQ + 128 * nB;
    f32x4 sa[2], sb[2]; v4u vreg[2][4]; v2u uur[2][8];
#pragma unroll
    for (int q = 0; q < 2; ++q) { sa[q] = (f32x4){0.f, 0.f, 0.f, 0.f}; sb[q] = sa[q];
        if (tid < 128) { sa[q] = *(const f32x4*)(SSQV + (size_t)(r0[q] + tid) * 8); sb[q] = *(const f32x4*)(SSQV + (size_t)(r0[q] + tid) * 8 + 4); }
#pragma unroll
        for (int it = 0; it < 4; ++it) { const int ch = tid + it * NTHR, sidx = ch & 127, d0 = (ch >> 7) * 8; vreg[q][it] = *(const v4u*)(VG + (size_t)(q ? bB : bA) * TMP_BSTRIDE + (size_t)(r0[q] + sidx) * 512 + h * 128 + d0); }
#pragma unroll
        for (int dt = 0; dt < 8; ++dt) uur[q][dt] = *(const v2u*)(U + (size_t)(q ? bB : bA) * TMP_BSTRIDE + (size_t)(r0[q] + t) * 512 + h * 128 + 16 * dt + 4 * g); }
    f32x4 wreg[8], gvr[8];
#pragma unroll
    for (int it = 0; it < 8; ++it) { const int ch = tid + it * NTHR, tt = ch >> 5, s0 = (ch & 31) * 4; wreg[it] = *(const f32x4*)(wsp + tt * 128 + s0); }
#pragma unroll
    for (int dt = 0; dt < 8; ++dt) gvr[dt] = *(const f32x4*)(gvg + 16 * dt + 4 * g);
    const float bsv = bsp[t];
    asm volatile("" ::: "memory");
    LBAR();
#pragma unroll
    for (int q = 0; q < 2; ++q) { LAS unsigned char* lq = lds + q * LQ; LAS float* sRS = (LAS float*)(lq + O_RS);
        if (tid < 128) sRS[tid] = rsqrtf((((sa[q][0] + sa[q][1]) + (sa[q][2] + sa[q][3])) + ((sb[q][0] + sb[q][1]) + (sb[q][2] + sb[q][3]))) * (1.f / 512.f) + EPS);
#pragma unroll
        for (int it = 0; it < 4; ++it) { const int ch = tid + it * NTHR, sidx = ch & 127, d0 = (ch >> 7) * 8; const v4u v = vreg[q][it];
#pragma unroll
            for (int e = 0; e < 4; ++e) { *(LAS unsigned short*)(lq + O_VG + (d0 + 2 * e) * (IMG_LD * 2) + sidx * 2) = (unsigned short)(v[e] & 0xffffu);
                                           *(LAS unsigned short*)(lq + O_VG + (d0 + 2 * e + 1) * (IMG_LD * 2) + sidx * 2) = (unsigned short)(v[e] >> 16); } } }
    LBAR();
#pragma unroll
    for (int q = 0; q < 2; ++q) { LAS unsigned char* lq = lds + q * LQ; const LAS float* sRS = (const LAS float*)(lq + O_RS);
#pragma unroll
        for (int it = 0; it < 8; ++it) { const int ch = tid + it * NTHR, tt = ch >> 5, s0 = (ch & 31) * 4; const f32x4 w = wreg[it];
            float v[4];
#pragma unroll
            for (int e = 0; e < 4; ++e) v[e] = (s0 + e <= tt) ? w[e] * sRS[s0 + e] : 0.f;
            *(LAS v2u*)(lq + O_WS + tt * (IMG_LD * 2) + s0 * 2) = pack4(v[0], v[1], v[2], v[3]); } }
    LBAR();
#pragma unroll
    for (int q = 0; q < 2; ++q) { LAS unsigned char* lq = lds + q * LQ;
        bf16x8 wf[4];
#pragma unroll
        for (int st = 0; st < 4; ++st) wf[st] = lds_frag(lq, O_WS, t, 32 * st + 8 * g);
#pragma unroll
        for (int dt = 0; dt < 8; ++dt) { f32x4 am = (f32x4){0.f, 0.f, 0.f, 0.f};
#pragma unroll
            for (int st = 0; st < 4; ++st) if (st < nst) am = MFMA16(lds_frag(lq, O_VG, 16 * dt + fr, 32 * st + 8 * g), wf[st], am);
            const int d0 = 16 * dt + 4 * g; const f32x4 gv = gvr[dt]; const v2u uu = uur[q][dt];
            const float u0 = __builtin_bit_cast(float, uu[0] << 16), u1 = __builtin_bit_cast(float, uu[0] & 0xffff0000u), u2 = __builtin_bit_cast(float, uu[1] << 16), u3 = __builtin_bit_cast(float, uu[1] & 0xffff0000u);
            *(v2u*)(YMIX + (size_t)(r0[q] + t) * 1024 + h * 128 + d0) = pack4(u0 * (am[0] * gv[0] + bsv), u1 * (am[1] * gv[1] + bsv), u2 * (am[2] * gv[2] + bsv), u3 * (am[3] * gv[3] + bsv)); }
        __builtin_amdgcn_sched_barrier(0); }
}

__device__ __forceinline__ void mlstm_out_unit(const float* const* in, unsigned char* ws, float* out, LAS unsigned char* lds, int l, int b, int h, int jj, int wave) {
    const int lane = lane_id_asm(), tid = wave * 64 + lane;
    constexpr int O_K = 0, O_V = IMG128, O_C = IMG128 + IMG144, O_P = IMG128 + 2 * IMG144, PW = 16 * IMG_LD * 2;
    const int r0 = b * SEQ + 128 * jj, ubase = (b * 4 + h) * 16;
    const float* UNITS = (const float*)(ws + WS_UNITS); const float* BT = (const float*)(ws + WS_BT);
    const size_t bo = (size_t)b * TMP_BSTRIDE;
    const bf16* Q = (const bf16*)(ws + WS_Q) + bo; const bf16* KP = (const bf16*)(ws + WS_KP) + bo; const bf16* VT = (const bf16*)(ws + WS_VT) + bo; const bf16* CONV = (const bf16*)(ws + WS_CONV) + bo; const bf16* OP = (const bf16*)(ws + WS_OP) + bo;
    bf16* YMIX = (bf16*)(ws + WS_YMIX); const float* UEX = (const float*)(ws + WS_UEXT) + (size_t)ubase * 144 * 128;
    USTAMP(80);
    const float cj = UNITS[(ubase + jj) * 4 + 0];
    const float sC = __expf(UNITS[(ubase + jj) * 4 + 2] - cj);
    const int fr = lane & 15, g = lane >> 4, t = 16 * wave + fr;
    v4u creg[5], kreg[4], vreg[4];
    { const bf16* CP = (const bf16*)(ws + WS_CPRE) + (size_t)(ubase + jj) * 18432;
#pragma unroll
      for (int it = 0; it < 5; ++it) { int ch = tid + it * NTHR; ch = ch < 2304 ? ch : 2303; creg[it] = *(const v4u*)(CP + (size_t)ch * 8); } }
#pragma unroll
    for (int it = 0; it < 4; ++it) { const int ch = tid + it * NTHR, row = ch >> 4, c16 = ch & 15;
        kreg[it] = *(const v4u*)(KP + (size_t)(r0 + row) * 512 + h * 128 + c16 * 8);
        vreg[it] = *(const v4u*)(VT + ((size_t)(b * 4 + h) * 128 + row) * SEQ + 128 * jj + c16 * 8); }
    bf16x8 qf[4];
#pragma unroll
    for (int st = 0; st < 4; ++st) qf[st] = *(const bf16x8*)(Q + (size_t)(r0 + t) * 512 + h * 128 + 32 * st + 8 * g);
    const float btv = BT[(size_t)(r0 + t) * 4 + h];
    v2u ovr[8], cvr[8];
#pragma unroll
    for (int dt = 0; dt < 8; ++dt) { ovr[dt] = *(const v2u*)(OP + (size_t)(r0 + t) * 512 + h * 128 + 16 * dt + 4 * g); cvr[dt] = *(const v2u*)(CONV + (size_t)(r0 + t) * 512 + h * 128 + 16 * dt + 4 * g); }
    const float* og = in[21] + (size_t)l * 512 + h * 128; const float* sk = in[22] + (size_t)l * 512 + h * 128;
    f32x4 ogr[8], skr[8];
#pragma unroll
    for (int dt = 0; dt < 8; ++dt) { ogr[dt] = *(const f32x4*)(og + 16 * dt + 4 * g); skr[dt] = *(const f32x4*)(sk + 16 * dt + 4 * g); }
    asm volatile("" ::: "memory");
    LBAR();
#pragma unroll
    for (int it = 0; it < 5; ++it) { int ch = tid + it * NTHR; ch = ch < 2304 ? ch : 2303;
        const int e = ch * 8, ic = e / 2304, rem = e - ic * 2304, d = rem >> 4, i = 16 * ic + (rem & 15);
        *(LAS v4u*)(lds + O_C + d * (IMG_LD * 2) + i * 2) = creg[it]; }
#pragma unroll
    for (int it = 0; it < 4; ++it) { const int ch = tid + it * NTHR, row = ch >> 4, c16 = ch & 15;
        *(LAS v4u*)(lds + O_K + row * (IMG_LD * 2) + c16 * 16) = kreg[it]; *(LAS v4u*)(lds + O_V + row * (IMG_LD * 2) + c16 * 16) = vreg[it]; }
    for (int i = tid; i < 16 * IMG_LD / 2; i += NTHR) { const int row = i / (IMG_LD / 2); ((LAS unsigned*)(lds + O_V + 128 * IMG_LD * 2))[i] = row == 0 ? 0x3f803f80u : 0u; }
    USTAMP(81);
    LBAR();
    USTAMP(82);
    const int pw = O_P + wave * PW;
    for (int n = 0; n <= wave; ++n) { f32x4 as = (f32x4){0.f, 0.f, 0.f, 0.f};
#pragma unroll
        for (int st = 0; st < 4; ++st) as = MFMA16(lds_frag(lds, O_K, 16 * n + fr, 32 * st + 8 * g), qf[st], as);
        if (n == wave) {
#pragma unroll
            for (int r = 0; r < 4; ++r) if (4 * g + r > fr) as[r] = 0.f; }
        *(LAS v2u*)(lds + pw + fr * (IMG_LD * 2) + (16 * n + 4 * g) * 2) = pack4(as[0], as[1], as[2], as[3]); }
    if ((wave & 1) == 0) { unsigned z; asm volatile("v_mov_b32 %0, 0" : "=v"(z));
        *(LAS v2u*)(lds + pw + fr * (IMG_LD * 2) + (16 * (wave + 1) + 4 * g) * 2) = (v2u){z, z}; }
    LDS_WAIT(); asm volatile("" ::: "memory");
    USTAMP(83);
    const int nst = (wave >> 1) + 1;
    bf16x8 pf[4];
#pragma unroll
    for (int st = 0; st < 4; ++st) pf[st] = (st < nst) ? lds_frag(lds, pw, fr, 32 * st + 8 * g) : qf[0];
    f32x4 hv[9];
#pragma unroll
    for (int dt = 0; dt < 9; ++dt) { f32x4 a2 = (f32x4){0.f, 0.f, 0.f, 0.f}, a3 = a2;
#pragma unroll
        for (int st = 0; st < 4; ++st) if (st < nst) a2 = MFMA16(lds_frag(lds, O_V, 16 * dt + fr, 32 * st + 8 * g), pf[st], a2);
#pragma unroll
        for (int st = 0; st < 4; ++st) a3 = MFMA16(lds_frag(lds, O_C, 16 * dt + fr, 32 * st + 8 * g), qf[st], a3);
        hv[dt] = a2 + a3 * sC; __builtin_amdgcn_sched_barrier(0); }
    USTAMP(84);
    const float den = __shfl(hv[8][0], fr);
    const float inv = __builtin_amdgcn_rcpf(fmaxf(fabsf(den), __expf(-(btv + cj))));
    float ss = 0.f;
#pragma unroll
    for (int dt = 0; dt < 8; ++dt) { hv[dt] = hv[dt] * inv; ss += (hv[dt][0] * hv[dt][0] + hv[dt][1] * hv[dt][1]) + (hv[dt][2] * hv[dt][2] + hv[dt][3] * hv[dt][3]); }
    ss += __shfl_xor(ss, 16); ss += __shfl_xor(ss, 32);
    const float rs = rsqrtf(ss * (1.f / 128.f) + EPS);
#pragma unroll
    for (int dt = 0; dt < 8; ++dt) { const int d0 = 16 * dt + 4 * g; const f32x4 ogv = ogr[dt], skv = skr[dt];
        const v2u ov = ovr[dt], cv = cvr[dt];
        float o[4], c[4];
        o[0] = __builtin_bit_cast(float, ov[0] << 16); o[1] = __builtin_bit_cast(float, ov[0] & 0xffff0000u); o[2] = __builtin_bit_cast(float, ov[1] << 16); o[3] = __builtin_bit_cast(float, ov[1] & 0xffff0000u);
        c[0] = __builtin_bit_cast(float, cv[0] << 16); c[1] = __builtin_bit_cast(float, cv[0] & 0xffff0000u); c[2] = __builtin_bit_cast(float, cv[1] << 16); c[3] = __builtin_bit_cast(float, cv[1] & 0xffff0000u);
        float y[4];
#pragma unroll
        for (int e = 0; e < 4; ++e) y[e] = sigmoid_f(o[e]) * (hv[dt][e] * rs * ogv[e] + skv[e] * c[e]);
        *(v2u*)(YMIX + (size_t)(r0 + t) * 1024 + 512 + h * 128 + d0) = pack4(y[0], y[1], y[2], y[3]); __builtin_amdgcn_sched_barrier(0); }
    USTAMP(85);
}
__device__ __forceinline__ void mlstm_scan_unit(unsigned char* ws, float* out, LAS unsigned char* lds, int l, int b, int h, int ic, int wave) {
    const int lane = lane_id_asm(), tid = wave * 64 + lane, ubase = (b * 4 + h) * 16;
    float* UNITS = (float*)(ws + WS_UNITS); const bf16* UEX = (const bf16*)(ws + WS_UEXT) + (size_t)ubase * 18432 + 16 * ic;
    bf16* CPRE = (bf16*)(ws + WS_CPRE) + (size_t)ubase * 18432 + ic * 2304;
    const bool two = tid < 64;
    const int off0 = (tid >> 2) * 128 + (tid & 3) * 4, off1 = two ? ((512 + tid) >> 2) * 128 + (tid & 3) * 4 : off0;
    float m = 0.f; f32x4 s0 = (f32x4){0.f, 0.f, 0.f, 0.f}, s1 = s0;
    __syncthreads();
#pragma unroll 1
    for (int xb = 0; xb < 16; xb += 8) {
        f32x4 u0[8], u1[8]; float cx[8], bl[8];
#pragma unroll
        for (int x = 0; x < 8; ++x) { const v2u p0 = *(const v2u*)(UEX + (size_t)(xb + x) * 18432 + off0), p1 = *(const v2u*)(UEX + (size_t)(xb + x) * 18432 + off1);
            u0[x] = (f32x4){__builtin_bit_cast(float, p0[0] << 16), __builtin_bit_cast(float, p0[0] & 0xffff0000u), __builtin_bit_cast(float, p0[1] << 16), __builtin_bit_cast(float, p0[1] & 0xffff0000u)};
            u1[x] = (f32x4){__builtin_bit_cast(float, p1[0] << 16), __builtin_bit_cast(float, p1[0] & 0xffff0000u), __builtin_bit_cast(float, p1[1] << 16), __builtin_bit_cast(float, p1[1] & 0xffff0000u)};
            cx[x] = UNITS[(ubase + xb + x) * 4 + 0]; bl[x] = UNITS[(ubase + xb + x) * 4 + 1]; }
        asm volatile("" ::: "memory");
#pragma unroll
        for (int x = 0; x < 8; ++x) {
            *(v2u*)(CPRE + (size_t)(xb + x) * 18432 + 4 * tid) = pack4(s0[0], s0[1], s0[2], s0[3]);
            if (two) *(v2u*)(CPRE + (size_t)(xb + x) * 18432 + 2048 + 4 * tid) = pack4(s1[0], s1[1], s1[2], s1[3]);
            if (ic == 0 && tid == 0) UNITS[(ubase + xb + x) * 4 + 2] = m;
            const float mn = fmaxf(bl[x] + m, bl[x] + cx[x]), fa = __expf(bl[x] + m - mn), fb = __expf(bl[x] + cx[x] - mn);
            s0 = s0 * fa + u0[x] * fb; s1 = s1 * fa + u1[x] * fb; m = mn; }
    }
    LAS float* T = (LAS float*)lds;
    { const int d = tid >> 2, i4 = (tid & 3) * 4;
#pragma unroll
      for (int k = 0; k < 4; ++k) T[(i4 + k) * 148 + d] = s0[k];
      if (two) { const int d1 = (512 + tid) >> 2;
#pragma unroll
          for (int k = 0; k < 4; ++k) T[(i4 + k) * 148 + d1] = s1[k]; } }
    __syncthreads();
    float* Cp = out + O_CP + (size_t)l * 524288 + (size_t)(b * 4 + h) * 16384 + (size_t)(16 * ic) * 128; float* Np = out + O_NP + (size_t)l * 4096 + (b * 4 + h) * 128 + 16 * ic;
    { const int i = tid >> 5, d4 = (tid & 31) * 4; *(f32x4*)(Cp + (size_t)i * 128 + d4) = *(const LAS f32x4*)(T + i * 148 + d4); }
    if (tid < 16) Np[tid] = T[tid * 148 + 128];
    if (ic == 0 && tid == 0) out[O_MP + l * 32 + b * 4 + h] = m;
}
}
namespace fk {
constexpr int ATT_LD = 264;
__device__ __forceinline__ void attn_unit(unsigned char* ws, LAS unsigned char* lds, int l, int pm, int h, int wave) {
    const int lane = lane_id_asm(), tid = wave * 64 + lane, fr = lane & 15, g = lane >> 4;
    const int b = pm >> 3;
    const bf16* QA = (const bf16*)(ws + WS_QA); bf16* ATT = (bf16*)(ws + WS_ATT);
    const bf16* KB = (const bf16*)(ws + WS_KB) + (size_t)l * 2097152 + (size_t)b * 256 * 1024 + h * 256;
    const bf16* VTB = (const bf16*)(ws + WS_VTB) + ((size_t)(l * 32 + b * 4 + h)) * 65536;
    { v4u kreg[16];
#pragma unroll
      for (int it = 0; it < 16; ++it) { const int ch = tid + it * NTHR, row = ch >> 5, c16 = ch & 31; kreg[it] = *(const v4u*)(KB + (size_t)row * 1024 + c16 * 8); }
      asm volatile("" ::: "memory");
      LBAR();
#pragma unroll
      for (int it = 0; it < 16; ++it) { const int ch = tid + it * NTHR, row = ch >> 5, c16 = ch & 31; *(LAS v4u*)(lds + row * (ATT_LD * 2) + c16 * 16) = kreg[it]; } }
    LBAR();
    bf16x8 pfr[2][8]; float inv[2];
    {
        const int rowa = pm * 256 + 32 * wave + fr;
        bf16x8 qa[8], qb[8];
#pragma unroll
        for (int st = 0; st < 8; ++st) { qa[st] = *(const bf16x8*)(QA + (size_t)rowa * 1024 + h * 256 + 32 * st + 8 * g); qb[st] = *(const bf16x8*)(QA + (size_t)(rowa + 16) * 1024 + h * 256 + 32 * st + 8 * g); }
        f32x4 sa[16], sb[16];
#pragma unroll
        for (int mt = 0; mt < 16; ++mt) { f32x4 a = (f32x4){0.f, 0.f, 0.f, 0.f}, c = a;
#pragma unroll
            for (int st = 0; st < 8; ++st) { const bf16x8 kf = *(const LAS bf16x8*)(lds + (16 * mt + fr) * (ATT_LD * 2) + (32 * st + 8 * g) * 2); a = MFMA16(kf, qa[st], a); c = MFMA16(kf, qb[st], c); }
            sa[mt] = a; sb[mt] = c; __builtin_amdgcn_sched_barrier(0); }
#define ATT_SOFTMAX(SV, TT) do { float mx = -3.0e38f; \
            _Pragma("unroll") for (int mt = 0; mt < 16; ++mt) mx = fmaxf(fmaxf(mx, fmaxf(SV[mt][0], SV[mt][1])), fmaxf(SV[mt][2], SV[mt][3])); \
            mx = fmaxf(mx, __shfl_xor(mx, 16)); mx = fmaxf(mx, __shfl_xor(mx, 32)); float sum = 0.f; \
            _Pragma("unroll") for (int mt = 0; mt < 16; ++mt) { _Pragma("unroll") for (int r = 0; r < 4; ++r) { const float p = __expf(SV[mt][r] - mx); SV[mt][r] = p; sum += p; } } \
            sum += __shfl_xor(sum, 16); sum += __shfl_xor(sum, 32); inv[TT] = __builtin_amdgcn_rcpf(sum); \
            _Pragma("unroll") for (int st = 0; st < 8; ++st) { const v4u w = (v4u){cvtpk(SV[2 * st][0], SV[2 * st][1]), cvtpk(SV[2 * st][2], SV[2 * st][3]), cvtpk(SV[2 * st + 1][0], SV[2 * st + 1][1]), cvtpk(SV[2 * st + 1][2], SV[2 * st + 1][3])}; \
                pfr[TT][st] = __builtin_bit_cast(bf16x8, w); } \
            __builtin_amdgcn_sched_barrier(0); } while (0)
        ATT_SOFTMAX(sa, 0);
        ATT_SOFTMAX(sb, 1);
#undef ATT_SOFTMAX
    }
    { const int tidb = wave * 64 + lane_id_asm();
      v4u vreg[16];
#pragma unroll
      for (int it = 0; it < 16; ++it) { const int ch = tidb + it * NTHR, row = ch >> 5, c16 = ch & 31; vreg[it] = *(const v4u*)(VTB + (size_t)row * 256 + c16 * 8); }
      asm volatile("" ::: "memory");
      LBAR();
#pragma unroll
      for (int it = 0; it < 16; ++it) { const int ch = tidb + it * NTHR, row = ch >> 5, c16 = ch & 31; *(LAS v4u*)(lds + row * (ATT_LD * 2) + c16 * 16) = vreg[it]; } }
    LBAR();
    const int lane2 = lane_id_asm(), fr2 = lane2 & 15, g2 = lane2 >> 4;
    const int row0 = pm * 256 + 32 * wave + fr2;
#pragma unroll 2
    for (int dt = 0; dt < 16; ++dt) { f32x4 a0 = (f32x4){0.f, 0.f, 0.f, 0.f}, a1 = a0;
#pragma unroll
        for (int st = 0; st < 8; ++st) { const LAS unsigned char* p = lds + (16 * dt + fr) * (ATT_LD * 2) + (32 * st + 4 * g) * 2;
            const v2u lo = *(const LAS v2u*)p, hi = *(const LAS v2u*)(p + 32); const v4u w = (v4u){lo[0], lo[1], hi[0], hi[1]}; const bf16x8 vf = __builtin_bit_cast(bf16x8, w);
            a0 = MFMA16(vf, pfr[0][st], a0); a1 = MFMA16(vf, pfr[1][st], a1); }
        *(v2u*)(ATT + (size_t)row0 * 1024 + h * 256 + 16 * dt + 4 * g2) = pack4(a0[0] * inv[0], a0[1] * inv[0], a0[2] * inv[0], a0[3] * inv[0]);
        *(v2u*)(ATT + (size_t)(row0 + 16) * 1024 + h * 256 + 16 * dt + 4 * g2) = pack4(a1[0] * inv[1], a1[1] * inv[1], a1[2] * inv[1], a1[3] * inv[1]);
        __builtin_amdgcn_sched_barrier(0); }
}
__device__ __forceinline__ void final_norm_rows(const bf16* XB, const float* SSQ, const float* gf, float* yp, float* ys, int gw_, int NGW, int xg) {
    const int lane = lane_id_asm(); int gw = gw_; asm volatile("" : "+s"(gw));
    const int LIM = xg < 0 ? MT : SEQ + 16;
    for (int i = gw; i < LIM; i += 2 * NGW) {
        const int i2 = (i + NGW < LIM) ? i + NGW : i;
        const int r = xg < 0 ? i : (i < SEQ ? SEQ * xg + i : M + 16 * xg + (i - SEQ)), r2 = xg < 0 ? i2 : (i2 < SEQ ? SEQ * xg + i2 : M + 16 * xg + (i2 - SEQ));
        v4u xa[2], xb[2]; f32x4 gv[4];
#pragma unroll
        for (int j = 0; j < 2; ++j) { xa[j] = *(const v4u*)(XB + (size_t)r * D + 8 * lane + 512 * j); xb[j] = *(const v4u*)(XB + (size_t)r2 * D + 8 * lane + 512 * j);
            gv[2 * j] = *(const f32x4*)(gf + 8 * lane + 512 * j); gv[2 * j + 1] = *(const f32x4*)(gf + 8 * lane + 512 * j + 4); }
        asm volatile("" ::: "memory");
        float sa = 0.f, sb = 0.f;
#pragma unroll
        for (int j = 0; j < 2; ++j)
#pragma unroll
            for (int e = 0; e < 4; ++e) { const float a0 = __builtin_bit_cast(float, xa[j][e] << 16), a1 = __builtin_bit_cast(float, xa[j][e] & 0xffff0000u), b0 = __builtin_bit_cast(float, xb[j][e] << 16), b1 = __builtin_bit_cast(float, xb[j][e] & 0xffff0000u); sa += a0 * a0 + a1 * a1; sb += b0 * b0 + b1 * b1; }
        const float ra = rsqrtf(wave_sum(sa) * (1.f / 1024.f) + EPS), rb = rsqrtf(wave_sum(sb) * (1.f / 1024.f) + EPS);
        float* da = r < M ? yp + (size_t)r * D : ys + (size_t)(r - M) * D; float* db = r2 < M ? yp + (size_t)r2 * D : ys + (size_t)(r2 - M) * D;
#pragma unroll
        for (int j = 0; j < 2; ++j) {
            f32x4 a0, a1, b0, b1;
#pragma unroll
            for (int e = 0; e < 2; ++e) { a0[2 * e] = __builtin_bit_cast(float, xa[j][e] << 16); a0[2 * e + 1] = __builtin_bit_cast(float, xa[j][e] & 0xffff0000u); a1[2 * e] = __builtin_bit_cast(float, xa[j][2 + e] << 16); a1[2 * e + 1] = __builtin_bit_cast(float, xa[j][2 + e] & 0xffff0000u);
                                           b0[2 * e] = __builtin_bit_cast(float, xb[j][e] << 16); b0[2 * e + 1] = __builtin_bit_cast(float, xb[j][e] & 0xffff0000u); b1[2 * e] = __builtin_bit_cast(float, xb[j][2 + e] << 16); b1[2 * e + 1] = __builtin_bit_cast(float, xb[j][2 + e] & 0xffff0000u); }
            *(f32x4*)(da + 8 * lane + 512 * j) = a0 * ra * gv[2 * j]; *(f32x4*)(da + 8 * lane + 512 * j + 4) = a1 * ra * gv[2 * j + 1];
            if (r2 != r) { *(f32x4*)(db + 8 * lane + 512 * j) = b0 * rb * gv[2 * j]; *(f32x4*)(db + 8 * lane + 512 * j + 4) = b1 * rb * gv[2 * j + 1]; } }
    }
}
}
namespace fk {
constexpr size_t WS_PROJS = WS_SAMP, WS_YMIXS = WS_SAMP + 1 * MiB, WS_QS = WS_SAMP + 2 * MiB, WS_ATTS = WS_SAMP + 3 * MiB, WS_HMIDS = WS_SAMP + 4 * MiB;
__device__ __forceinline__ float block_sum512(float v, LAS float* red, int wave, int lane) {
    v = wave_sum(v); if (lane == 0) red[wave] = v; __syncthreads();
    float s = ((red[0] + red[1]) + (red[2] + red[3])) + ((red[4] + red[5]) + (red[6] + red[7])); __syncthreads(); return s;
}
template <int MODE, int NT>
__device__ __forceinline__ void skinny_unit(unsigned char* ws, LAS unsigned char* lds, const bf16* A, int lda, const bf16* Bt, int K, int rg, int cg, float* outf, int ldo, bf16* outb, int wave) {
    const int lane = lane_id_asm(), tid = wave * 64 + lane, fr = lane & 15, g = lane >> 4;
    constexpr int NC = 16 * NT;
    const int ks = K >> 3, k0 = wave * ks;
    const bf16* ap = A + (size_t)(16 * rg + fr) * lda + k0 + 8 * g;
    const bf16* bp = Bt + (size_t)(NC * cg + fr) * K + k0 + 8 * g;
    constexpr int PR = NC / 2;
    const int row = (tid / PR) & 15, c2 = (tid % PR) * 2, grow = M + 16 * rg + row, col = NC * cg + c2; const bool epi = tid < 16 * PR;
    unsigned xo = 0u; unsigned* XP = (unsigned*)((bf16*)(ws + WS_XB) + (size_t)grow * D + col);
    if (MODE == 1) xo = *XP;
    f32x4 acc[NT]; float ssq = 0.f;
#pragma unroll
    for (int nt = 0; nt < NT; ++nt) acc[nt] = (f32x4){0.f, 0.f, 0.f, 0.f};
    for (int kk = 0; kk < ks; kk += 128) {
        bf16x8 af[4], bfr[NT][4];
#pragma unroll
        for (int st = 0; st < 4; ++st) { af[st] = *(const bf16x8*)(ap + kk + 32 * st);
#pragma unroll
            for (int nt = 0; nt < NT; ++nt) bfr[nt][st] = *(const bf16x8*)(bp + (size_t)(16 * nt) * K + kk + 32 * st); }
        if (MODE != 1) {
#pragma unroll
            for (int st = 0; st < 4; ++st) { const v4u w = __builtin_bit_cast(v4u, af[st]);
#pragma unroll
                for (int e = 0; e < 4; ++e) { const float lo = __builtin_bit_cast(float, w[e] << 16), hi = __builtin_bit_cast(float, w[e] & 0xffff0000u); ssq += lo * lo + hi * hi; } } }
#pragma unroll
        for (int st = 0; st < 4; ++st)
#pragma unroll
            for (int nt = 0; nt < NT; ++nt) acc[nt] = MFMA16(bfr[nt][st], af[st], acc[nt]);
    }
    LBAR();
    LAS float* red = (LAS float*)lds;
    LAS float* rsq = red + 8 * 16 * NC;
#pragma unroll
    for (int nt = 0; nt < NT; ++nt) *(LAS f32x4*)(red + wave * (16 * NC) + fr * NC + 16 * nt + 4 * g) = acc[nt];
    if (MODE != 1) { ssq += __shfl_xor(ssq, 16); ssq += __shfl_xor(ssq, 32); if (g == 0) rsq[wave * 16 + fr] = ssq; }
    LBAR();
    if (!epi) return;
    float v0 = 0.f, v1 = 0.f;
#pragma unroll
    for (int w = 0; w < 8; ++w) { const f32x2 p = *(const LAS f32x2*)(red + w * (16 * NC) + row * NC + c2); v0 += p[0]; v1 += p[1]; }
    float rs = 1.f;
    if (MODE != 1) { float t = 0.f;
#pragma unroll
        for (int w = 0; w < 8; ++w) t += rsq[w * 16 + row];
        rs = rsqrtf(t * (1.f / 1024.f) + EPS); }
    if (MODE == 0) { *(f32x2*)(outf + (size_t)(16 * rg + row) * ldo + col) = (f32x2){v0 * rs, v1 * rs}; }
    else if (MODE == 2) { const float a = fmaxf(v0 * rs, 0.f), b = fmaxf(v1 * rs, 0.f);
        *(unsigned*)(outb + (size_t)(16 * rg + row) * ldo + col) = cvtpk(a * a, b * b); }
    else { const float x0 = __builtin_bit_cast(float, xo << 16) + v0, x1 = __builtin_bit_cast(float, xo & 0xffff0000u) + v1; *XP = cvtpk(x0, x1); }
}
struct PreSkinnyResid { unsigned char* ws; LAS unsigned char* lds; const bf16* A; const bf16* Bt; int K, vcu, G, wave;
    __device__ __forceinline__ void operator()() const { for (int u = vcu; u < 256; u += G) skinny_unit<1, 2>(ws, lds + 32768, A, K, Bt, K, u >> 5, u & 31, nullptr, 0, nullptr, wave); LBAR(); } };
__device__ __forceinline__ void skinny_pair_up(unsigned char* ws, LAS unsigned char* lds, const bf16* A, const bf16* Bt, int rg, int cg, bf16* outb, int wave) {
    const int lane = lane_id_asm(), tid = wave * 64 + lane, fr = lane & 15, g = lane >> 4;
    constexpr int K = 1024, NT = 4, NC = 64, ldo = 4096;
    const int k0 = wave * 128;
    const bf16* bp = Bt + (size_t)(NC * cg + fr) * K + k0 + 8 * g;
    bf16x8 af[2][4], bfr[NT][4];
#pragma unroll
    for (int st = 0; st < 4; ++st) {
#pragma unroll
        for (int q = 0; q < 2; ++q) af[q][st] = *(const bf16x8*)(A + (size_t)(16 * (rg + 4 * q) + fr) * K + k0 + 8 * g + 32 * st);
#pragma unroll
        for (int nt = 0; nt < NT; ++nt) bfr[nt][st] = *(const bf16x8*)(bp + (size_t)(16 * nt) * K + 32 * st); }
    f32x4 acc[2][NT]; float ssq[2];
#pragma unroll
    for (int q = 0; q < 2; ++q) { ssq[q] = 0.f;
#pragma unroll
        for (int nt = 0; nt < NT; ++nt) acc[q][nt] = (f32x4){0.f, 0.f, 0.f, 0.f};
#pragma unroll
        for (int st = 0; st < 4; ++st) { const v4u w = __builtin_bit_cast(v4u, af[q][st]);
#pragma unroll
            for (int e = 0; e < 4; ++e) { const float lo = __builtin_bit_cast(float, w[e] << 16), hi = __builtin_bit_cast(float, w[e] & 0xffff0000u); ssq[q] += lo * lo + hi * hi; }
#pragma unroll
            for (int nt = 0; nt < NT; ++nt) acc[q][nt] = MFMA16(bfr[nt][st], af[q][st], acc[q][nt]); } }
    LBAR();
    LAS float* red = (LAS float*)lds;
    LAS float* rsq = red + 2 * 8 * 16 * NC;
#pragma unroll
    for (int q = 0; q < 2; ++q) {
#pragma unroll
        for (int nt = 0; nt < NT; ++nt) *(LAS f32x4*)(red + (q * 8 + wave) * (16 * NC) + fr * NC + 16 * nt + 4 * g) = acc[q][nt];
        float t = ssq[q]; t += __shfl_xor(t, 16); t += __shfl_xor(t, 32); if (g == 0) rsq[(q * 8 + wave) * 16 + fr] = t; }
    LBAR();
    const int row = tid >> 5, c2 = (tid & 31) * 2, col = NC * cg + c2;
#pragma unroll
    for (int q = 0; q < 2; ++q) { float v0 = 0.f, v1 = 0.f, t = 0.f;
#pragma unroll
        for (int w = 0; w < 8; ++w) { const f32x2 p = *(const LAS f32x2*)(red + (q * 8 + w) * (16 * NC) + row * NC + c2); v0 += p[0]; v1 += p[1]; t += rsq[(q * 8 + w) * 16 + row]; }
        const float rs = rsqrtf(t * (1.f / 1024.f) + EPS); const float a = fmaxf(v0 * rs, 0.f), b = fmaxf(v1 * rs, 0.f);
        *(unsigned*)(outb + (size_t)(16 * (rg + 4 * q) + row) * ldo + col) = cvtpk(a * a, b * b); }
}
__device__ __forceinline__ void sample_mix_unit(const float* const* in, unsigned char* ws, float* out, LAS unsigned char* lds, int l, int b, int h, int wave) {
    const int lane = lane_id_asm(), tid = wave * 64 + lane;
    LAS float* red = (LAS float*)lds; LAS float* sconv = red + 16; LAS float* sxm = sconv + 128; LAS float* sq = sxm + 128; LAS float* sk = sq + 128; LAS float* sv = sk + 128; LAS float* snum = sv + 128;
    const float* PROJ = (const float*)(ws + WS_PROJS) + (size_t)b * 2048; bf16* YM = (bf16*)(ws + WS_YMIXS) + (size_t)b * 1024; const float* GATES = (const float*)(ws + WS_GATES) + (size_t)(M + b) * 8;
    const int v = tid & 127, kg = tid >> 7; const size_t so = ((size_t)(l * 128 + b) * 4 + h) * 16384;
    const float* C0 = in[5] + so + (size_t)(kg * 32) * 128 + v; float c0v[32];
#pragma unroll
    for (int kk = 0; kk < 32; ++kk) c0v[kk] = __builtin_nontemporal_load(C0 + kk * 128);
    const float* Wq = in[16] + (size_t)l * 65536 + (size_t)h * 16384 + (size_t)(32 * kg) * 128 + v; const float* Wk = in[17] + (size_t)l * 65536 + (size_t)h * 16384 + (size_t)(32 * kg) * 128 + v;
    const float* Wv = in[18] + (size_t)l * 65536 + (size_t)h * 16384 + (size_t)(32 * kg) * 128 + v;
    float wqv[32], wkv[32], wvv[32];
#pragma unroll
    for (int d = 0; d < 32; ++d) { wqv[d] = Wq[d * 128]; wkv[d] = Wk[d * 128]; wvv[d] = Wv[d * 128]; }
    const float pv_raw = PROJ[512 + tid], pu_raw = PROJ[tid];
    float xm = 0.f, s0 = 0.f, s1 = 0.f, s2 = 0.f, cw0 = 0.f, cw1 = 0.f, cw2 = 0.f, cw3 = 0.f, cbv = 0.f, opre = 0.f, n0v = 0.f;
    if (tid < 128) { const int c = h * 128 + tid; xm = PROJ[1024 + c]; opre = PROJ[1536 + c]; const float* sc = in[8] + ((size_t)(l * 128 + b) * 3) * 512 + c; const float* cw = in[14] + (size_t)l * 2048 + c;
        s0 = sc[0]; s1 = sc[512]; s2 = sc[1024]; cw0 = cw[0]; cw1 = cw[512]; cw2 = cw[1024]; cw3 = cw[1536]; cbv = in[15][l * 512 + c]; n0v = in[6][((size_t)(l * 128 + b) * 4 + h) * 128 + tid]; }
    const float ig = GATES[h] + in[19][l * 4 + h]; const float z = GATES[4 + h] + in[20][l * 4 + h]; const float m0 = in[7][l * 512 + b * 4 + h];
    const float gvg = in[11][l * 512 + tid], ws00 = in[12][(size_t)l * 65536 + (size_t)h * 16384], bs0 = in[13][l * 512 + h * 128];
    float ogv = 0.f, skv = 0.f; if (tid < 128) { ogv = in[21][l * 512 + h * 128 + tid]; skv = in[22][l * 512 + h * 128 + tid]; }
    asm volatile("" ::: "memory");
    LBAR();
    const float vraw = gelu_f(pv_raw);
    { float t = wave_sum(vraw * vraw); if (lane == 0) red[wave] = t; }
    if (tid < 128) { const float a = cbv + cw0 * s0 + cw1 * s1 + cw2 * s2 + cw3 * xm; sconv[tid] = a * sigmoid_f(a); sxm[tid] = xm; }
    LBAR();
    const float rsv = rsqrtf((((red[0] + red[1]) + (red[2] + red[3])) + ((red[4] + red[5]) + (red[6] + red[7]))) * (1.f / 512.f) + EPS);
    const float vn = vraw * rsv * gvg;
    if (h == 0) out[O_GV + (size_t)l * 65536 + b * 512 + tid] = vn;
    if ((tid >> 7) == h) YM[tid] = (bf16)f2bf(gelu_f(pu_raw) * (ws00 * vn + bs0));
    if (tid < 128) { float* co = out + O_CVS + (size_t)l * 196608 + (size_t)b * 1536 + h * 128 + tid; co[0] = s1; co[512] = s2; co[1024] = xm; }
    {
        float pq = 0.f, pk = 0.f, pvv = 0.f;
#pragma unroll
        for (int d = 0; d < 32; ++d) { const float c = sconv[32 * kg + d]; pq += c * wqv[d]; pk += c * wkv[d]; pvv += sxm[32 * kg + d] * wvv[d]; }
        snum[tid] = pq; snum[512 + tid] = pk; snum[1024 + tid] = pvv; }
    LBAR();
    if (tid < 384) { const int which = tid >> 7, e = tid & 127; const LAS float* pp = snum + which * 512 + e; const float a = (pp[0] + pp[128]) + (pp[256] + pp[384]);
        if (which == 0) sq[e] = a; else if (which == 1) sk[e] = a * 0.08838834764831845f; else sv[e] = a; }
    const float lf = fminf(z, 0.f) - __logf(1.f + __expf(-fabsf(z)));
    const float mn = fmaxf(lf + m0, ig), fd = __expf(lf + m0 - mn), iw = __expf(ig - mn);
    LBAR();
    float num = 0.f;
    {
        float* Co = out + O_CS + so + (size_t)(kg * 32) * 128 + v; const float ivv = iw * sv[v];
#pragma unroll
        for (int kk = 0; kk < 32; ++kk) { const float c = fd * c0v[kk] + sk[kg * 32 + kk] * ivv; __builtin_nontemporal_store(c, Co + kk * 128); num += sq[kg * 32 + kk] * c; }
    }
    float dp = 0.f;
    if (tid < 128) { const float nn = fd * n0v + iw * sk[tid]; out[O_NS + ((size_t)(l * 128 + b) * 4 + h) * 128 + tid] = nn; dp = sq[tid] * nn; }
    dp = wave_sum(dp);
    LBAR();
    snum[kg * 128 + v] = num; if (lane == 0) red[wave] = dp;
    LBAR();
    const float den = red[0] + red[1];
    float hv = 0.f;
    if (tid < 128) hv = ((snum[tid] + snum[128 + tid]) + (snum[256 + tid] + snum[384 + tid])) * __builtin_amdgcn_rcpf(fmaxf(fabsf(den), __expf(-mn)));
    { float t = wave_sum(hv * hv); if (lane == 0) red[8 + wave] = t; }
    LBAR();
    const float rs = rsqrtf((red[8] + red[9]) * (1.f / 128.f) + EPS);
    if (tid < 128) { const int c = h * 128 + tid;
        YM[512 + c] = (bf16)f2bf(sigmoid_f(opre) * (hv * rs * ogv + skv * sconv[tid]));
        if (tid == 0) out[O_MS + l * 512 + b * 4 + h] = mn; }
}
__device__ __forceinline__ void sample_mix_pair(const float* const* in, unsigned char* ws, float* out, LAS unsigned char* lds, int l, int bA, int bB, int h, int wave) {
    const int lane = lane_id_asm(), tid = wave * 64 + lane;
    constexpr int LQ = 12288;
    const int v = tid & 127, kg = tid >> 7;
    int bb[2]; bb[0] = bA; bb[1] = bB;
    const float* Wq = in[16] + (size_t)l * 65536 + (size_t)h * 16384 + (size_t)(32 * kg) * 128 + v; const float* Wk = in[17] + (size_t)l * 65536 + (size_t)h * 16384 + (size_t)(32 * kg) * 128 + v;
    const float* Wv = in[18] + (size_t)l * 65536 + (size_t)h * 16384 + (size_t)(32 * kg) * 128 + v;
    float wqv[32], wkv[32], wvv[32];
#pragma unroll
    for (int d = 0; d < 32; ++d) { wqv[d] = Wq[d * 128]; wkv[d] = Wk[d * 128]; wvv[d] = Wv[d * 128]; }
    float cw0 = 0.f, cw1 = 0.f, cw2 = 0.f, cw3 = 0.f, cbv = 0.f, ogv = 0.f, skv = 0.f;
    if (tid < 128) { const int c = h * 128 + tid; const float* cw = in[14] + (size_t)l * 2048 + c; cw0 = cw[0]; cw1 = cw[512]; cw2 = cw[1024]; cw3 = cw[1536]; cbv = in[15][l * 512 + c]; ogv = in[21][l * 512 + c]; skv = in[22][l * 512 + c]; }
    const float gvg = in[11][l * 512 + tid], ws00 = in[12][(size_t)l * 65536 + (size_t)h * 16384], bs0 = in[13][l * 512 + h * 128], bi = in[19][l * 4 + h], bfv = in[20][l * 4 + h];
    float c0v[2][32], pv_raw[2], pu_raw[2], xm[2], s0[2], s1[2], s2[2], opre[2], n0v[2], gi[2], gz[2], m0[2];
#pragma unroll
    for (int q = 0; q < 2; ++q) { const int b = bb[q]; const size_t so = ((size_t)(l * 128 + b) * 4 + h) * 16384;
        const float* C0 = in[5] + so + (size_t)(kg * 32) * 128 + v;
#pragma unroll
        for (int kk = 0; kk < 32; ++kk) c0v[q][kk] = __builtin_nontemporal_load(C0 + kk * 128);
        const float* PROJ = (const float*)(ws + WS_PROJS) + (size_t)b * 2048; const float* GATES = (const float*)(ws + WS_GATES) + (size_t)(M + b) * 8;
        pv_raw[q] = PROJ[512 + tid]; pu_raw[q] = PROJ[tid];
        xm[q] = 0.f; s0[q] = 0.f; s1[q] = 0.f; s2[q] = 0.f; opre[q] = 0.f; n0v[q] = 0.f;
        if (tid < 128) { const int c = h * 128 + tid; xm[q] = PROJ[1024 + c]; opre[q] = PROJ[1536 + c]; const float* sc = in[8] + ((size_t)(l * 128 + b) * 3) * 512 + c;
            s0[q] = sc[0]; s1[q] = sc[512]; s2[q] = sc[1024]; n0v[q] = in[6][((size_t)(l * 128 + b) * 4 + h) * 128 + tid]; }
        gi[q] = GATES[h]; gz[q] = GATES[4 + h]; m0[q] = in[7][l * 512 + b * 4 + h]; }
    asm volatile("" ::: "memory");
    LBAR();
    float vraw[2];
#pragma unroll
    for (int q = 0; q < 2; ++q) { LAS float* red = (LAS float*)(lds + q * LQ); LAS float* sconv = red + 16; LAS float* sxm = sconv + 128;
        vraw[q] = gelu_f(pv_raw[q]);
        { float t = wave_sum(vraw[q] * vraw[q]); if (lane == 0) red[wave] = t; }
        if (tid < 128) { const float a = cbv + cw0 * s0[q] + cw1 * s1[q] + cw2 * s2[q] + cw3 * xm[q]; sconv[tid] = a * sigmoid_f(a); sxm[tid] = xm[q]; } }
    LBAR();
#pragma unroll
    for (int q = 0; q < 2; ++q) { const int b = bb[q]; LAS float* red = (LAS float*)(lds + q * LQ); LAS float* sconv = red + 16; LAS float* sxm = sconv + 128; LAS float* snum = sxm + 128 + 384;
        bf16* YM = (bf16*)(ws + WS_YMIXS) + (size_t)b * 1024;
        const float rsv = rsqrtf((((red[0] + red[1]) + (red[2] + red[3])) + ((red[4] + red[5]) + (red[6] + red[7]))) * (1.f / 512.f) + EPS);
        const float vn = vraw[q] * rsv * gvg;
        if (h == 0) out[O_GV + (size_t)l * 65536 + b * 512 + tid] = vn;
        if ((tid >> 7) == h) YM[tid] = (bf16)f2bf(gelu_f(pu_raw[q]) * (ws00 * vn + bs0));
        if (tid < 128) { float* co = out + O_CVS + (size_t)l * 196608 + (size_t)b * 1536 + h * 128 + tid; co[0] = s1[q]; co[512] = s2[q]; co[1024] = xm[q]; }
        float pq = 0.f, pk = 0.f, pvv = 0.f;
#pragma unroll
        for (int d = 0; d < 32; ++d) { const float c = sconv[32 * kg + d]; pq += c * wqv[d]; pk += c * wkv[d]; pvv += sxm[32 * kg + d] * wvv[d]; }
        snum[tid] = pq; snum[512 + tid] = pk; snum[1024 + tid] = pvv; }
    LBAR();
#pragma unroll
    for (int q = 0; q < 2; ++q) { LAS float* red = (LAS float*)(lds + q * LQ); LAS float* sq = red + 16 + 256; LAS float* sk = sq + 128; LAS float* sv = sk + 128; LAS float* snum = sv + 128;
        if (tid < 384) { const int which = tid >> 7, e = tid & 127; const LAS float* pp = snum + which * 512 + e; const float a = (pp[0] + pp[128]) + (pp[256] + pp[384]);
            if (which == 0) sq[e] = a; else if (which == 1) sk[e] = a * 0.08838834764831845f; else sv[e] = a; } }
    LBAR();
    float num[2], dpv[2], mnv[2];
#pragma unroll
    for (int q = 0; q < 2; ++q) { const int b = bb[q]; LAS float* red = (LAS float*)(lds + q * LQ); LAS float* sq = red + 16 + 256; LAS float* sk = sq + 128; LAS float* sv = sk + 128;
        const float ig = gi[q] + bi, z = gz[q] + bfv; const float lf = fminf(z, 0.f) - __logf(1.f + __expf(-fabsf(z)));
        const float mn = fmaxf(lf + m0[q], ig), fd = __expf(lf + m0[q] - mn), iw = __expf(ig - mn); mnv[q] = mn;
        const size_t so = ((size_t)(l * 128 + b) * 4 + h) * 16384; float* Co = out + O_CS + so + (size_t)(kg * 32) * 128 + v; const float ivv = iw * sv[v];
        float nm = 0.f;
#pragma unroll
        for (int kk = 0; kk < 32; ++kk) { const float c = fd * c0v[q][kk] + sk[kg * 32 + kk] * ivv; __builtin_nontemporal_store(c, Co + kk * 128); nm += sq[kg * 32 + kk] * c; }
        num[q] = nm;
        float dp = 0.f;
        if (tid < 128) { const float nn = fd * n0v[q] + iw * sk[tid]; out[O_NS + ((size_t)(l * 128 + b) * 4 + h) * 128 + tid] = nn; dp = sq[tid] * nn; }
        dpv[q] = wave_sum(dp); }
    LBAR();
#pragma unroll
    for (int q = 0; q < 2; ++q) { LAS float* red = (LAS float*)(lds + q * LQ); LAS float* snum = red + 16 + 256 + 384; snum[kg * 128 + v] = num[q]; if (lane == 0) red[wave] = dpv[q]; }
    LBAR();
    float hv[2];
#pragma unroll
    for (int q = 0; q < 2; ++q) { LAS float* red = (LAS float*)(lds + q * LQ); LAS float* snum = red + 16 + 256 + 384;
        const float den = red[0] + red[1]; hv[q] = 0.f;
        if (tid < 128) hv[q] = ((snum[tid] + snum[128 + tid]) + (snum[256 + tid] + snum[384 + tid])) * __builtin_amdgcn_rcpf(fmaxf(fabsf(den), __expf(-mnv[q])));
        { float t = wave_sum(hv[q] * hv[q]); if (lane == 0) red[8 + wave] = t; } }
    LBAR();
#pragma unroll
    for (int q = 0; q < 2; ++q) { const int b = bb[q]; LAS float* red = (LAS float*)(lds + q * LQ); LAS float* sconv = red + 16; bf16* YM = (bf16*)(ws + WS_YMIXS) + (size_t)b * 1024;
        const float rs = rsqrtf((red[8] + red[9]) * (1.f / 128.f) + EPS);
        if (tid < 128) { const int c = h * 128 + tid; YM[512 + c] = (bf16)f2bf(sigmoid_f(opre[q]) * (hv[q] * rs * ogv + skv * sconv[tid]));
            if (tid == 0) out[O_MS + l * 512 + b * 4 + h] = mnv[q]; } }
}
__device__ __forceinline__ void sample_attn_unit(const float* const* in, unsigned char* ws, LAS unsigned char* lds, int l, int b, int h, int wave) {
    const int lane = lane_id_asm(), tid = wave * 64 + lane;
    LAS float* red = (LAS float*)lds; LAS float* sp = red + 16; LAS float* sacc = sp + 256;
    const float* Kc = in[3] + ((size_t)(l * 128 + b) * 256) * 1024 + h * 256 + 4 * lane; const float* Vc = in[4] + ((size_t)(l * 128 + b) * 256) * 1024 + h * 256 + 4 * lane;
    const f32x4 q = *(const f32x4*)((const float*)(ws + WS_QS) + (size_t)b * 1024 + h * 256 + 4 * lane);
    LBAR();
    float myscore = 0.f;
    {
        f32x4 kv[32];
#pragma unroll
        for (int i = 0; i < 32; ++i) kv[i] = __builtin_nontemporal_load((const f32x4*)(Kc + (size_t)(32 * wave + i) * 1024));
        float dv[32];
#pragma unroll
        for (int i = 0; i < 32; ++i) dv[i] = (kv[i][0] * q[0] + kv[i][1] * q[1]) + (kv[i][2] * q[2] + kv[i][3] * q[3]);
#pragma unroll
        for (int i = 0; i < 16; ++i) { const bool up = (lane & 32) != 0; const float send = up ? dv[i] : dv[i + 16], keep = up ? dv[i + 16] : dv[i]; dv[i] = keep + __shfl_xor(send, 32); }
#pragma unroll
        for (int i = 0; i < 8; ++i) { const bool up = (lane & 16) != 0; const float send = up ? dv[i] : dv[i + 8], keep = up ? dv[i + 8] : dv[i]; dv[i] = keep + __shfl_xor(send, 16); }
#pragma unroll
        for (int i = 0; i < 4; ++i) { const bool up = (lane & 8) != 0; const float send = up ? dv[i] : dv[i + 4], keep = up ? dv[i + 4] : dv[i]; dv[i] = keep + __shfl_xor(send, 8); }
#pragma unroll
        for (int i = 0; i < 2; ++i) { const bool up = (lane & 4) != 0; const float send = up ? dv[i] : dv[i + 2], keep = up ? dv[i + 2] : dv[i]; dv[i] = keep + __shfl_xor(send, 4); }
        { const bool up = (lane & 2) != 0; const float send = up ? dv[0] : dv[1], keep = up ? dv[1] : dv[0]; dv[0] = keep + __shfl_xor(send, 2); }
        myscore = dv[0] + __shfl_xor(dv[0], 1);
    }
    f32x4 vv[32];
#pragma unroll
    for (int i = 0; i < 32; ++i) vv[i] = __builtin_nontemporal_load((const f32x4*)(Vc + (size_t)(32 * wave + i) * 1024));
    asm volatile("" ::: "memory");
    if (!(lane & 1)) sp[32 * wave + (lane >> 1)] = myscore;
    LBAR();
    float s = tid < 256 ? sp[tid] : -3.0e38f; float mx = s;
#pragma unroll
    for (int o = 1; o < 64; o <<= 1) mx = fmaxf(mx, __shfl_xor(mx, o));
    if (lane == 0) red[wave] = mx;
    LBAR();
    mx = fmaxf(fmaxf(red[0], red[1]), fmaxf(red[2], red[3]));
    const float p = tid < 256 ? __expf(s - mx) : 0.f;
    { const float t = wave_sum(p); if (lane == 0) red[8 + wave] = t; }
    LBAR();
    const float tot = ((red[8] + red[9]) + (red[10] + red[11])) + ((red[12] + red[13]) + (red[14] + red[15]));
    if (tid < 256) sp[tid] = p * __builtin_amdgcn_rcpf(tot);
    LBAR();
    f32x4 acc = (f32x4){0.f, 0.f, 0.f, 0.f};
#pragma unroll
    for (int i = 0; i < 32; ++i) acc += vv[i] * sp[32 * wave + i];
    *(LAS f32x4*)(sacc + wave * 256 + 4 * lane) = acc;
    LBAR();
    if (tid < 256) { float a = 0.f;
#pragma unroll
        for (int w = 0; w < 8; ++w) a += sacc[w * 256 + tid];
        ((bf16*)(ws + WS_ATTS))[(size_t)b * 1024 + h * 256 + tid] = (bf16)f2bf(a); }
}
}
namespace fk {
constexpr int PH_PREP = 0, PH_MEMKV = 1, PH_L0 = 2, PH_PER_LAYER = 10, PH_FINAL = 22, NPH = 23;
constexpr int LP_G1 = 0, LP_M1 = 1, LP_SCAN = 2, LP_M2 = 3, LP_G2 = 4, LP_G3 = 5, LP_ATT = 6, LP_G4 = 7, LP_G5 = 8, LP_G6 = 9;
struct Args { const float* in[34]; float* out; unsigned char* ws; int ph_lo, ph_hi, region, pad; };

__global__ void __launch_bounds__(NTHR, 2) fwd(Args a) {
    extern __shared__ __attribute__((aligned(16))) unsigned char lds_raw[];
    LAS unsigned char* lds = (LAS unsigned char*)lds_raw;
    volatile LAS unsigned* MISC = (volatile LAS unsigned*)(lds + MISC_OFF);
    const int tid = threadIdx.x, wave = __builtin_amdgcn_readfirstlane(tid >> 6);
    const int G = gridDim.x, bx = blockIdx.x;
    const int vcu = (G % 8 == 0) ? (bx % 8) * (G / 8) + bx / 8 : bx;
    unsigned char* ws = a.ws; float* out = a.out;
    unsigned* ctl = (unsigned*)(ws + WS_CTL);
    if (tid < 64) MISC[tid] = 0u;
    if (tid == 0) __hip_atomic_store(ctl + CW_XID + vcu, xb_xcc_id() + 1u, __ATOMIC_RELAXED, __HIP_MEMORY_SCOPE_AGENT);
    __syncthreads();
    XcdBarrier bar = xcd_barrier_post(ctl + CW_BAR + a.region * XCD_BAR_WORDS, MISC + 8);
    const int lo = a.ph_lo, hi = a.ph_hi;
#define IN(k) (lo <= (k) && (k) < hi)
#ifdef FK_STAMPS
#define STAMP(k) do { if (bx == 0 && wave == 0 && lane_id_asm() == 0) ((unsigned long long*)(ctl + 32768))[k] = __builtin_amdgcn_s_memrealtime(); } while (0)
#else
#define STAMP(k) do { } while (0)
#endif
#ifdef FK_STAMPS
#define ARRIVE(k) do { if (wave == 0 && lane_id_asm() == 0) ((unsigned long long*)(ctl + 65536))[(k) * 256 + bx] = __builtin_amdgcn_s_memrealtime(); } while (0)
#else
#define ARRIVE(k) do { } while (0)
#endif
#define SEAM(k) do { if (IN(k) && IN((k) + 1)) { ARRIVE(k); xcd_barrier(bar, wave); } STAMP((k) + 1); } while (0)
#define SEAM_L(k) do { if (IN(k) && IN((k) + 1)) { ARRIVE(k); if (MISC[12] != 0u) xcd_local_barrier(ctl, bar.bar, vcu >> 5, MISC + 8, wave); else xcd_barrier(bar, wave); } STAMP((k) + 1); } while (0)
    STAMP(0);
    const int gw = vcu * NWAVES + wave, NGW = G * NWAVES;

    if (IN(PH_PREP)) { p0_prologue<0>(a.in, ws, lds, gw, NGW, wave); }
    SEAM(PH_PREP);
    if (IN(PH_PREP) && IN(PH_MEMKV) && G == 256) {
        if (wave == 0) { const int ln = lane_id_asm(); bool ok = true;
#pragma unroll
            for (int q = 0; q < 4; ++q) { const int v = 4 * ln + q; const unsigned mine = __hip_atomic_load(ctl + CW_XID + v, __ATOMIC_RELAXED, __HIP_MEMORY_SCOPE_AGENT), head = __hip_atomic_load(ctl + CW_XID + (v & ~31), __ATOMIC_RELAXED, __HIP_MEMORY_SCOPE_AGENT);
                ok = ok && mine != 0u && mine == head; }
            const bool all_ok = __builtin_amdgcn_ballot_w64(ok) == ~0ull;
            if (ln == 0) MISC[12] = all_ok ? 1u : 0u; }
        __syncthreads();
    }
    if (IN(PH_MEMKV)) {
        pg8::Gemm g{(const bf16*)(ws + WS_MB), (const bf16*)(ws + WS_WMEM), 2048, 4096, 1024}; pg8::StaticOrder S; S.init(2048, 4096, G, bx);
        EpiMemKV E{out, (bf16*)(ws + WS_KB), (bf16*)(ws + WS_VTB), (const float*)(ws + WS_SSQM)};
        pg8::gemm_phase<EpiMemKV, pg8::StaticOrder, true, true>(lds, g, S, E, wave);
        if (G == 256 && bx >= 128) p0_prologue<1>(a.in, ws, lds, (bx - 128) * NWAVES + wave, 128 * NWAVES, wave);
        else if (G != 256) p0_prologue<1>(a.in, ws, lds, gw, NGW, wave);
    }
    if (IN(PH_MEMKV)) __syncthreads();
    STAMP(PH_MEMKV + 1);
    unsigned char* const ws0 = ws;
#pragma unroll 1
    for (int l = 0; l < 2; ++l) {
        unsigned char* ws = ws0; asm volatile("" : "+s"(ws));
        const int pb = PH_L0 + PH_PER_LAYER * l;
        if (IN(pb + LP_G1)) { asm volatile("" : "+s"(ws));
            if (l == 0) STAMP(90);
            { const int wg = wave * 32 + (vcu & 31);
              gate_prelude_mfma(ws, lds, l, wg < 128 ? 128 * (vcu >> 5) + wg : (wg == 128 ? 1024 + (vcu >> 5) : 1 << 20), wave); }
            if (l == 0) STAMP(91);
            for (int u = vcu; u < 256; u += G) skinny_unit<0, 4>(ws, lds, (const bf16*)(ws + WS_XB) + (size_t)M * D, 1024, (const bf16*)(ws + WS_WIN) + (size_t)l * 2048 * 1024, 1024, u >> 5, u & 31, (float*)(ws + WS_PROJS), 2048, nullptr, wave);
            __syncthreads();
            pg8::Gemm g{(const bf16*)(ws + WS_XB), (const bf16*)(ws + WS_WIN) + (size_t)l * 2048 * 1024, M, 2048, 1024};
#ifdef FK_STAMPS
            if (l == 0) { g.stamps = (unsigned long long*)(ctl + 32768) + 93; STAMP(92); }
#endif
            pg8::StaticOrder S; S.init(M, 2048, G, bx);
            rstd_table_fill(lds, S, (const float*)(ws + WS_SSQ), wave);
            EpiG1 E{(bf16*)(ws + WS_U), (bf16*)(ws + WS_VG), (bf16*)(ws + WS_XM), (bf16*)(ws + WS_OP), lds, (float*)(ws + WS_SSQV), out + O_CVP + (size_t)l * 12288};
            pg8::gemm_phase<EpiG1, pg8::StaticOrder, true, true>(lds, g, S, E, wave);
        }
        if (l == 0) SEAM(pb + LP_G1); else SEAM_L(pb + LP_G1);
        if (IN(pb + LP_M1)) { asm volatile("" : "+s"(ws));
            const int xg = vcu >> 5, j = vcu & 31;
#pragma unroll 1
            for (int k = 0; k < 4; ++k) { const int kk = (vcu & 1) ? (k + 1) % 4 : k;
                if (kk == 0) sample_mix_pair(a.in, ws, out, lds, l, 16 * xg + (j >> 2), 16 * xg + (j >> 2) + 8, j & 3, wave);
                else if (kk < 3) { const int w = j + 32 * (kk - 1); mlstm_local_unit(a.in, ws, lds, l, xg, w >> 4, w & 15, wave); }
                else gmlp_pair(a.in, ws, lds, l, xg, xg, j >> 2, (j >> 2) + 8, j & 3, wave);
            }
        }
        SEAM_L(pb + LP_M1);
        if (IN(pb + LP_SCAN)) { asm volatile("" : "+s"(ws)); for (int u = vcu; u < 256; u += G) mlstm_scan_unit(ws, out, lds, l, u >> 5, (u >> 3) & 3, u & 7, wave); __syncthreads();
            for (int u = vcu; u < 256; u += G) skinny_unit<1, 2>(ws, lds, (const bf16*)(ws + WS_YMIXS), 1024, (const bf16*)(ws + WS_WOUT) + (size_t)l * 1048576, 1024, u >> 5, u & 31, nullptr, 0, nullptr, wave);
            __syncthreads(); }
        SEAM_L(pb + LP_SCAN);
        if (IN(pb + LP_M2)) { asm volatile("" : "+s"(ws));
            for (int k = 0; k < 2; ++k) { const int w = (vcu & 31) + 32 * k; mlstm_out_unit(a.in, ws, out, lds, l, vcu >> 5, w >> 4, w & 15, wave); }
            __syncthreads();
            for (int u = vcu; u < 256; u += G) skinny_unit<0, 2>(ws, lds, (const bf16*)(ws + WS_XB) + (size_t)M * D, 1024, (const bf16*)(ws + WS_WCQ) + (size_t)l * 1048576, 1024, u >> 5, u & 31, (float*)(ws + WS_QS), 1024, nullptr, wave);
            __syncthreads();
        }
        SEAM_L(pb + LP_M2);
        if (IN(pb + LP_G2)) { asm volatile("" : "+s"(ws));
            pg8::Gemm g{(const bf16*)(ws + WS_YMIX), (const bf16*)(ws + WS_WOUT) + (size_t)l * 1048576, M, 1024, 1024}; pg8::StaticOrder S; S.init(M, 1024, G, bx);
            EpiResid E{(bf16*)(ws + WS_XB), (float*)(ws + WS_SSQ)};
            pg8::gemm_phase<EpiResid, pg8::StaticOrder, true, true>(lds, g, S, E, wave);
        }
        SEAM_L(pb + LP_G2);
        if (IN(pb + LP_ATT)) { asm volatile("" : "+s"(ws));
            pg8::Gemm g{(const bf16*)(ws + WS_XB), (const bf16*)(ws + WS_WCQ) + (size_t)l * 1048576, M, 1024, 1024}; pg8::StaticOrder S; S.init(M, 1024, G, bx);
            EpiScaleBf16<0> E{(bf16*)(ws + WS_QA), 1024, lds};
            pg8::Unit myu; myu.pm = 0; myu.pn = 0; (void)S.next(0, myu);
            const int sstep = (vcu % 3 == 0) ? 0 : ((vcu % 3 == 1) ? 2 : 1);
#pragma unroll 1
            for (int step = 0; step < 3; ++step) {
                if (step == sstep) { for (int k = 0; k < 2; ++k) sample_attn_unit(a.in, ws, lds, l, 16 * (vcu >> 5) + ((vcu & 31) >> 1), 2 * (vcu & 1) + k, wave); __syncthreads(); }
                if (step == 0) { rstd_table_fill(lds, S, (const float*)(ws + WS_SSQ), wave); pg8::gemm_phase<EpiScaleBf16<0>, pg8::StaticOrder, true, true>(lds, g, S, E, wave); __syncthreads(); }
                if (step == 1) attn_unit(ws, lds, l, myu.pm, myu.pn, wave);
            }
            __syncthreads();
        }
        SEAM_L(pb + LP_ATT);
        if (IN(pb + LP_G4)) { asm volatile("" : "+s"(ws));
            pg8::Gemm g{(const bf16*)(ws + WS_ATT), (const bf16*)(ws + WS_WCO) + (size_t)l * 1048576, M, 1024, 1024}; pg8::StaticOrder S; S.init(M, 1024, G, bx);
            EpiResid E{(bf16*)(ws + WS_XB), (float*)(ws + WS_SSQ)};
            PreSkinnyResid P{ws, lds, (const bf16*)(ws + WS_ATTS), (const bf16*)(ws + WS_WCO) + (size_t)l * 1048576, 1024, vcu, G, wave};
            pg8::gemm_phase<EpiResid, pg8::StaticOrder, true, true, PreSkinnyResid>(lds, g, S, E, wave, P);
        }
        SEAM_L(pb + LP_G4);
        if (IN(pb + LP_G5)) { asm volatile("" : "+s"(ws));
            for (int k = 0; k < 2; ++k) skinny_unit<2, 4>(ws, lds, (const bf16*)(ws + WS_XB) + (size_t)M * D, 1024, (const bf16*)(ws + WS_WUP) + (size_t)l * 4194304, 1024, vcu >> 5, (vcu & 31) + 32 * k, nullptr, 4096, (bf16*)(ws + WS_HMIDS), wave);
            __syncthreads();
            pg8::Gemm g{(const bf16*)(ws + WS_XB), (const bf16*)(ws + WS_WUP) + (size_t)l * 4194304, M, 4096, 1024};
#ifdef FK_STAMPS
            if (l == 0) { g.stamps = (unsigned long long*)(ctl + 32768) + 70; STAMP(69); }
#endif
            pg8::StaticOrder S; S.init(M, 4096, G, bx);
            rstd_table_fill(lds, S, (const float*)(ws + WS_SSQ), wave);
            EpiScaleBf16<1> E{(bf16*)(ws + WS_HMID), 4096, lds};
            pg8::gemm_phase<EpiScaleBf16<1>, pg8::StaticOrder, true, true>(lds, g, S, E, wave);
        }
        SEAM_L(pb + LP_G5);
        if (IN(pb + LP_G6)) { asm volatile("" : "+s"(ws));
            pg8::Gemm g{(const bf16*)(ws + WS_HMID), (const bf16*)(ws + WS_WDOWN) + (size_t)l * 4194304, M, 1024, 4096}; pg8::StaticOrder S; S.init(M, 1024, G, bx);
            EpiResid E{(bf16*)(ws + WS_XB), (float*)(ws + WS_SSQ)};
            PreSkinnyResid P{ws, lds, (const bf16*)(ws + WS_HMIDS), (const bf16*)(ws + WS_WDOWN) + (size_t)l * 4194304, 4096, vcu, G, wave};
            pg8::gemm_phase<EpiResid, pg8::StaticOrder, true, true, PreSkinnyResid>(lds, g, S, E, wave, P);
        }
        SEAM_L(pb + LP_G6);
    }
    if (IN(PH_FINAL)) { if (G == 256) final_norm_rows((const bf16*)(ws + WS_XB), (const float*)(ws + WS_SSQ), a.in[33], out + O_YP, out + O_YS, (vcu & 31) * NWAVES + wave, 32 * NWAVES, vcu >> 5);
        else final_norm_rows((const bf16*)(ws + WS_XB), (const float*)(ws + WS_SSQ), a.in[33], out + O_YP, out + O_YS, gw, NGW, -1); __syncthreads(); STAMP(PH_FINAL + 1); }
#ifdef FK_STAMPS
    xcd_barrier(bar, wave); STAMP(30); xcd_barrier(bar, wave); STAMP(31); xcd_barrier(bar, wave); STAMP(32);
#endif
#undef IN
#undef SEAM
}

static int g_grid = 0;
static void launch(hipStream_t st, void* const* d_in, float* out, unsigned char* wsf, int ph_lo, int ph_hi, int region) {
    if (g_grid == 0) {
        int dev = 0, cus = 0;
        if (hipGetDevice(&dev) != hipSuccess || hipDeviceGetAttribute(&cus, hipDeviceAttributeMultiprocessorCount, dev) != hipSuccess) { fprintf(stderr, "kernel_launch: device query failed\n"); g_grid = -1; return; }
        if (hipFuncSetAttribute((const void*)fwd, hipFuncAttributeMaxDynamicSharedMemorySize, LDS_BYTES) != hipSuccess) { fprintf(stderr, "kernel_launch: hipFuncSetAttribute failed\n"); g_grid = -1; return; }
        int per_cu = 0;
        if (hipOccupancyMaxActiveBlocksPerMultiprocessor(&per_cu, (const void*)fwd, NTHR, LDS_BYTES) != hipSuccess || per_cu < 1) fprintf(stderr, "kernel_launch: occupancy query says %d\n", per_cu);
        (void)hipGetLastError();
        if (cus < 256) { fprintf(stderr, "kernel_launch: this kernel needs 256 CUs (found %d)\n", cus); g_grid = -1; return; }
        g_grid = 256;
    }
    if (g_grid < 0) return;
    Args a{};
    for (int i = 0; i < 34; ++i) a.in[i] = (const float*)d_in[i];
    a.out = out; a.ws = wsf; a.ph_lo = ph_lo; a.ph_hi = ph_hi; a.region = region; a.pad = 0;
    hipLaunchKernelGGL(fwd, dim3(g_grid), dim3(NTHR), LDS_BYTES, st, a);
}
}
extern "C" void kernel_launch(void* const* d_in, const int* in_sizes, int n_in, void* d_out, int out_size, void* d_ws, size_t ws_size, hipStream_t stream) {
    using namespace fk;
    if (n_in != 34 || out_size != (int)O_END || ws_size < WS_FAST_END) { fprintf(stderr, "kernel_launch: unexpected problem shape (n_in %d, out %d, ws %zu)\n", n_in, out_size, ws_size); return; }
    (void)hipMemsetAsync((unsigned char*)d_ws + WS_CTL, 0, 32768, stream);
    fk::launch(stream, d_in, (float*)d_out, (unsigned char*)d_ws, 0, NPH, 0);
}
```
